# Optimizing an MI355X kernel written in HIP

```python
import math
import jax
import jax.numpy as jnp
from jax import lax
import numpy as np

D_MODEL = 2048
BATCH = 16
SEQ = 256
DEPTH = 2
DEC_BATCH = 8
DEC_SEQ = 2048
PAST_LEN = 256

GRID_W = 64
HEAD_DIM = 128
ROPE_QUARTER = HEAD_DIM // 4
ROPE_THETA = 10000.0
NORM_EPS = 1e-6
Q_BLOCK = 128

A_HEADS = 8
A_DK = 128
A_DV = 128
A_CHUNK = 32
A_W = A_HEADS * A_DV
B_HEADS = 8
B_KV_HEADS = 2
B_GROUP = B_HEADS // B_KV_HEADS
B_W = B_HEADS * HEAD_DIM
C_HEADS = 16
C_KV_HEADS = 4
C_GROUP = C_HEADS // C_KV_HEADS
C_W = C_HEADS * HEAD_DIM
WINDOW = 128

L0_SIZES = (A_HEADS * A_DK, A_HEADS * A_DK, A_HEADS * A_DK, A_W, A_W,
            B_W, B_KV_HEADS * HEAD_DIM, B_KV_HEADS * HEAD_DIM, B_W)
L0_IN = 3 * A_HEADS * A_DK + 2 * A_W + 2 * B_W + 2 * B_KV_HEADS * HEAD_DIM
L1_SIZES = (C_W, C_KV_HEADS * HEAD_DIM, C_KV_HEADS * HEAD_DIM, C_W)
L1_IN = 2 * C_W + 2 * C_KV_HEADS * HEAD_DIM

kernel_name = "hybrid_hgrn2_axialgqa_swa_prefix_dit_step"


def _split(u, sizes):
    out, start = [], 0
    for s in sizes:
        out.append(u[..., start:start + s])
        start += s
    return out


def _rmsnorm(x, g):
    xf = x.astype(jnp.float32)
    y = xf * lax.rsqrt(jnp.mean(xf * xf, axis=-1, keepdims=True) + NORM_EPS)
    return (y * g.astype(jnp.float32)).astype(x.dtype)


def _adaln(cond, w_mod, b_mod):
    m = jax.nn.silu(cond) @ w_mod + b_mod
    return jnp.split(m, 3, axis=-1)


def _modulate(x, norm_g, shift, scale):
    return _rmsnorm(x, norm_g) * (1.0 + scale) + shift


def _axial_rope_tables(n_tokens):
    rows = n_tokens // GRID_W
    row = jnp.repeat(jnp.arange(rows), GRID_W).astype(jnp.float32)
    col = (jnp.arange(rows * GRID_W) % GRID_W).astype(jnp.float32)
    inv = ROPE_THETA ** (-jnp.arange(ROPE_QUARTER, dtype=jnp.float32) / ROPE_QUARTER)
    ar = row[:, None] * inv
    ac = col[:, None] * inv
    ang = jnp.concatenate([ar, ar, ac, ac], axis=-1)
    return jnp.cos(ang), jnp.sin(ang)


def _apply_rope(x, cos, sin):
    shp = (x.shape[1],) + (1,) * (x.ndim - 3) + (HEAD_DIM,)
    xr = x.reshape(x.shape[:-1] + (2, 2, ROPE_QUARTER))
    rot = jnp.stack([-xr[..., 1, :], xr[..., 0, :]], axis=-2).reshape(x.shape)
    return x * cos.reshape(shp).astype(x.dtype) + rot * sin.reshape(shp).astype(x.dtype)


def _attend(q, k, v, mask=None, sink=None):
    s = jnp.einsum('bqhgd,bkhd->bhgqk', q.astype(jnp.float32), k.astype(jnp.float32))
    s = s / math.sqrt(HEAD_DIM)
    if mask is not None:
        s = jnp.where(mask, s, -jnp.inf)
    if sink is not None:
        sk = jnp.broadcast_to(sink.astype(jnp.float32)[None, :, :, None, None], s.shape[:-1] + (1,))
        p = jax.nn.softmax(jnp.concatenate([s, sk], axis=-1), axis=-1)[..., :-1]
    else:
        p = jax.nn.softmax(s, axis=-1)
    return jnp.einsum('bhgqk,bkhd->bqhgd', p.astype(v.dtype), v)


def _blocked_dense(q, k, v, sink=None):
    bsz, lq = q.shape[:2]
    nb = lq // Q_BLOCK
    qb = jnp.moveaxis(q.reshape((bsz, nb, Q_BLOCK) + q.shape[2:]), 1, 0)
    out = lax.map(lambda qi: _attend(qi, k, v, None, sink), qb)
    return jnp.moveaxis(out, 0, 1).reshape(q.shape)


def _banded_window(q, k, v, k_ctx, v_ctx, sink):
    bsz, L = q.shape[:2]
    nb = L // Q_BLOCK
    pad = ((0, 0), (Q_BLOCK, Q_BLOCK), (0, 0), (0, 0))
    kp = jnp.pad(k, pad)
    vp = jnp.pad(v, pad)
    qb = jnp.moveaxis(q.reshape((bsz, nb, Q_BLOCK) + q.shape[2:]), 1, 0)
    r = jnp.arange(Q_BLOCK)
    cidx = jnp.arange(3 * Q_BLOCK)
    ctx_mask = jnp.ones((Q_BLOCK, k_ctx.shape[1]), dtype=bool)

    def blk(args):
        b, qi = args
        kw = lax.dynamic_slice_in_dim(kp, b * Q_BLOCK, 3 * Q_BLOCK, axis=1)
        vw = lax.dynamic_slice_in_dim(vp, b * Q_BLOCK, 3 * Q_BLOCK, axis=1)
        qpos = b * Q_BLOCK + r
        kpos = (b - 1) * Q_BLOCK + cidx
        band = (jnp.abs(qpos[:, None] - kpos[None, :]) <= WINDOW) & (kpos >= 0)[None, :] & (kpos < L)[None, :]
        mask = jnp.concatenate([band, ctx_mask], axis=1)
        return _attend(qi, jnp.concatenate([kw, k_ctx], axis=1),
                       jnp.concatenate([vw, v_ctx], axis=1), mask, sink)

    out = lax.map(blk, (jnp.arange(nb), qb))
    return jnp.moveaxis(out, 0, 1).reshape(q.shape)


def _hgrn2_chunk_scan(q, k, v, logf, s0):
    bsz, L, H, _ = q.shape
    dv = v.shape[-1]
    n = L // A_CHUNK

    def chunks(t):
        return t.reshape(bsz, n, A_CHUNK, H, t.shape[-1])

    q, k, v, logf = chunks(q), chunks(k), chunks(v), chunks(logf)
    b = jnp.cumsum(logf, axis=2)
    b_last = b[:, :, -1:]
    q_dec = q * jnp.exp(b)
    k_inv = k * jnp.exp(-b)
    k_end = k * jnp.exp(b_last - b)
    causal = jnp.tril(jnp.ones((A_CHUNK, A_CHUNK), dtype=bool))
    att = jnp.where(causal, jnp.einsum('bnthd,bnshd->bnhts', q_dec, k_inv), 0.0)
    o_intra = jnp.einsum('bnhts,bnshv->bnthv', att, v)

    def step(S, xs):
        qd, ke, vc, dec = xs
        o = jnp.einsum('bthd,bhdv->bthv', qd, S)
        S = dec[..., None] * S + jnp.einsum('bshd,bshv->bhdv', ke, vc)
        return S, o

    xs = (jnp.moveaxis(q_dec, 1, 0), jnp.moveaxis(k_end, 1, 0), jnp.moveaxis(v, 1, 0),
          jnp.moveaxis(jnp.exp(b_last[:, :, 0]), 1, 0))
    s_final, o_inter = lax.scan(step, s0, xs)
    o = o_intra + jnp.moveaxis(o_inter, 0, 1)
    return o.reshape(bsz, L, H, dv), s_final


def _layer0_mixer(h, w_in, w_out, lb, a_onorm, b_qnorm, b_knorm, ctx, rope):
    bsz, L, _ = h.shape
    aq, af_f, af_b, ai, ag, bq, bk, bv, bg = _split(h @ w_in, L0_SIZES)
    q = jax.nn.silu(aq.astype(jnp.float32)).reshape(bsz, L, A_HEADS, A_DK)
    v = ai.astype(jnp.float32).reshape(bsz, L, A_HEADS, A_DV)

    def gates(fr, lbd):
        f = lbd + (1.0 - lbd) * jax.nn.sigmoid(fr.astype(jnp.float32).reshape(bsz, L, A_HEADS, A_DK))
        return 1.0 - f, jnp.log(f)

    k_f, lf_f = gates(af_f, lb[0].reshape(A_HEADS, A_DK))
    k_b, lf_b = gates(af_b, lb[1].reshape(A_HEADS, A_DK))
    if ctx is None:
        s0f = jnp.zeros((bsz, A_HEADS, A_DK, A_DV), jnp.float32)
        s0b = s0f
    else:
        s0f = ctx[0][:, 0].astype(jnp.float32)
        s0b = ctx[0][:, 1].astype(jnp.float32)
    o_f, s_f = _hgrn2_chunk_scan(q, k_f, v, lf_f, s0f)
    flip = lambda t: jnp.flip(t, axis=1)
    o_bw, s_b = _hgrn2_chunk_scan(flip(q), flip(k_b), flip(v), flip(lf_b), s0b)
    o_a = _rmsnorm(o_f + flip(o_bw), a_onorm).reshape(bsz, L, A_W).astype(h.dtype) * jax.nn.silu(ag)
    qb = _rmsnorm(bq.reshape(bsz, L, B_KV_HEADS, B_GROUP, HEAD_DIM), b_qnorm)
    kb = _rmsnorm(bk.reshape(bsz, L, B_KV_HEADS, HEAD_DIM), b_knorm)
    vb = bv.reshape(bsz, L, B_KV_HEADS, HEAD_DIM)
    if ctx is None:
        o_b = _blocked_dense(qb, kb, vb)
    else:
        cos, sin = rope
        o_b = _blocked_dense(_apply_rope(qb, cos, sin),
                             jnp.concatenate([_apply_rope(kb, cos, sin), ctx[1]], axis=1),
                             jnp.concatenate([vb, ctx[2]], axis=1))
    o_b = o_b.reshape(bsz, L, B_W) * jax.nn.silu(bg)
    y = jnp.concatenate([o_a, o_b], axis=-1) @ w_out
    if ctx is None:
        return y, (jnp.stack([s_f, s_b], axis=1).astype(h.dtype), kb, vb)
    return y, None


def _layer1_mixer(h, w_in, w_out, qnorm, knorm, sink, ctx, rope):
    bsz, L, _ = h.shape
    cq, ck, cv, cg = _split(h @ w_in, L1_SIZES)
    q = _rmsnorm(cq.reshape(bsz, L, C_KV_HEADS, C_GROUP, HEAD_DIM), qnorm)
    k = _rmsnorm(ck.reshape(bsz, L, C_KV_HEADS, HEAD_DIM), knorm)
    v = cv.reshape(bsz, L, C_KV_HEADS, HEAD_DIM)
    sink_g = sink.reshape(C_KV_HEADS, C_GROUP)
    if ctx is None:
        o = _blocked_dense(q, k, v, sink_g)
    else:
        cos, sin = rope
        o = _banded_window(_apply_rope(q, cos, sin), _apply_rope(k, cos, sin), v, ctx[0], ctx[1], sink_g)
    y = (o.reshape(bsz, L, C_W) * jax.nn.silu(cg)) @ w_out
    if ctx is None:
        return y, (k, v)
    return y, None


def setup_inputs(seed: int = 0) -> dict:
    key = jax.random.key(seed)
    ks = jax.random.split(key, 32)
    D = D_MODEL

    def nrm(k, shape, s):
        return jax.random.normal(k, shape, jnp.float32) * s

    return {
        "x_prompt": nrm(ks[0], (BATCH, SEQ, D), 1.0),
        "x_sample": nrm(ks[1], (DEC_BATCH, DEC_SEQ, D), 1.0),
        "state_l0_hgrn": nrm(ks[2], (DEC_BATCH, 2, A_HEADS, A_DK, A_DV), 0.5),
        "cache_l0_k": nrm(ks[3], (DEC_BATCH, PAST_LEN, B_KV_HEADS, HEAD_DIM), 1.0),
        "cache_l0_v": nrm(ks[4], (DEC_BATCH, PAST_LEN, B_KV_HEADS, HEAD_DIM), 1.0),
        "cache_l1_k": nrm(ks[5], (DEC_BATCH, PAST_LEN, C_KV_HEADS, HEAD_DIM), 1.0),
        "cache_l1_v": nrm(ks[6], (DEC_BATCH, PAST_LEN, C_KV_HEADS, HEAD_DIM), 1.0),
        "c": nrm(ks[7], (DEC_BATCH, D), 1.0),
        "c_ctx": nrm(ks[8], (D,), 1.0),
        "lb_gamma": nrm(ks[9], (DEPTH + 1, 2, A_HEADS * A_DK), 0.1),
        "l0_norm": 1.0 + nrm(ks[10], (D,), 0.1),
        "l0_w_mod": nrm(ks[11], (D, 3 * D), D ** -0.5),
        "l0_b_mod": nrm(ks[12], (3 * D,), 0.02),
        "l0_w_in": nrm(ks[13], (D, L0_IN), D ** -0.5),
        "l0_w_out": nrm(ks[14], (A_W + B_W, D), (A_W + B_W) ** -0.5),
        "l0_a_onorm": 1.0 + nrm(ks[15], (A_DV,), 0.1),
        "l0_b_qnorm": 1.0 + nrm(ks[16], (HEAD_DIM,), 0.1),
        "l0_b_knorm": 1.0 + nrm(ks[17], (HEAD_DIM,), 0.1),
        "l1_norm": 1.0 + nrm(ks[18], (D,), 0.1),
        "l1_w_mod": nrm(ks[19], (D, 3 * D), D ** -0.5),
        "l1_b_mod": nrm(ks[20], (3 * D,), 0.02),
        "l1_w_in": nrm(ks[21], (D, L1_IN), D ** -0.5),
        "l1_w_out": nrm(ks[22], (C_W, D), C_W ** -0.5),
        "l1_c_qnorm": 1.0 + nrm(ks[23], (HEAD_DIM,), 0.1),
        "l1_c_knorm": 1.0 + nrm(ks[24], (HEAD_DIM,), 0.1),
        "l1_c_sink": nrm(ks[25], (C_HEADS,), 0.5),
    }


def reference(x_prompt, x_sample, state_l0_hgrn, cache_l0_k, cache_l0_v, cache_l1_k, cache_l1_v,
              c, c_ctx, lb_gamma,
              l0_norm, l0_w_mod, l0_b_mod, l0_w_in, l0_w_out, l0_a_onorm, l0_b_qnorm, l0_b_knorm,
              l1_norm, l1_w_mod, l1_b_mod, l1_w_in, l1_w_out, l1_c_qnorm, l1_c_knorm, l1_c_sink):
    lb_all = jnp.cumsum(jax.nn.softmax(lb_gamma.astype(jnp.float32), axis=0), axis=0)
    rope = _axial_rope_tables(x_sample.shape[1])
    mod_params = [(l0_norm, l0_w_mod, l0_b_mod), (l1_norm, l1_w_mod, l1_b_mod)]
    y_prompt, y_sample = x_prompt, x_sample
    for layer in range(DEPTH):
        norm_g, w_mod, b_mod = mod_params[layer]
        sh_p, sc_p, gt_p = _adaln(c_ctx, w_mod, b_mod)
        sh_s, sc_s, gt_s = _adaln(c[:, None, :], w_mod, b_mod)
        h_p = _modulate(y_prompt, norm_g, sh_p, sc_p)
        h_s = _modulate(y_sample, norm_g, sh_s, sc_s)
        if layer % 2 == 0:
            lb = lb_all[layer]
            out_p, (new_state_l0_hgrn, new_cache_l0_k, new_cache_l0_v) = _layer0_mixer(
                h_p, l0_w_in, l0_w_out, lb, l0_a_onorm, l0_b_qnorm, l0_b_knorm, None, None)
            out_s, _ = _layer0_mixer(
                h_s, l0_w_in, l0_w_out, lb, l0_a_onorm, l0_b_qnorm, l0_b_knorm,
                (state_l0_hgrn, cache_l0_k, cache_l0_v), rope)
        else:
            out_p, (new_cache_l1_k, new_cache_l1_v) = _layer1_mixer(
                h_p, l1_w_in, l1_w_out, l1_c_qnorm, l1_c_knorm, l1_c_sink, None, None)
            out_s, _ = _layer1_mixer(
                h_s, l1_w_in, l1_w_out, l1_c_qnorm, l1_c_knorm, l1_c_sink,
                (cache_l1_k, cache_l1_v), rope)
        y_prompt = y_prompt + gt_p * out_p
        y_sample = y_sample + gt_s * out_s
    return (y_prompt, y_sample, new_state_l0_hgrn, new_cache_l0_k, new_cache_l0_v, new_cache_l1_k, new_cache_l1_v)
```

```cpp
#include <hip/hip_runtime.h>
#include <hip/hip_cooperative_groups.h>
#include <cstdio>
#include <cstdint>
namespace cg = cooperative_groups;

#ifndef PHSEL
#define PHSEL 0xFFF
#endif
#ifndef MK_MULTI
#define MK_MULTI 1
#endif

constexpr int NTOK = 20480, NPTOK = 4096, DM = 2048;
constexpr int LDU0 = 7680, LDU1 = 5120;
constexpr size_t WS_WT_IN0 = 0;
constexpr size_t WS_WT_OUT0 = WS_WT_IN0 + (size_t)7680 * 2048 * 2;
constexpr size_t WS_WT_IN1 = WS_WT_OUT0 + (size_t)2048 * 2048 * 2;
constexpr size_t WS_WT_OUT1 = WS_WT_IN1 + (size_t)5120 * 2048 * 2;
constexpr size_t WS_MOD = WS_WT_OUT1 + (size_t)2048 * 2048 * 2;
constexpr size_t WS_LB = WS_MOD + (size_t)2 * 9 * 6144 * 4;
constexpr size_t WS_H = WS_LB + 8192;
constexpr size_t WS_U = WS_H + (size_t)NTOK * 2048 * 2;
constexpr size_t WS_KS = WS_U + (size_t)NTOK * 7680 * 2;
constexpr size_t WS_VS = WS_KS + (size_t)8 * 4 * 2304 * 128 * 2;
constexpr size_t WS_KP = WS_VS + (size_t)8 * 4 * 2304 * 128 * 2;
constexpr size_t WS_VP = WS_KP + (size_t)16 * 4 * 256 * 128 * 2;
constexpr size_t WS_END = WS_VP + (size_t)16 * 4 * 256 * 128 * 2;
constexpr size_t OUT_STATE = 41943040, OUT_L0K = 46137344, OUT_L0V = 47185920, OUT_L1K = 48234496, OUT_L1V = 50331648;
constexpr int LDS_BYTES = 67584 + 65536;

struct Params { const float* in[26]; float* out; char* ws; };

namespace pg8 {
#define PG8_LAS __attribute__((address_space(3)))
typedef unsigned short bf16_t;
typedef short bf16x8 __attribute__((ext_vector_type(8)));
typedef float f32x4 __attribute__((ext_vector_type(4)));
typedef unsigned u32x4 __attribute__((ext_vector_type(4)));
constexpr int BM = 256, BK = 64, HALF = 128, HTB = HALF * BK * 2  , STAGE_BYTES = 8 * HTB, NXCD = 8, WGM = 8;

__host__ __device__ __forceinline__ int lds_byte(int r, int c) { const int st = (r >> 4) * 2 + (c >> 5), rr = r & 15, cc = c & 31, ob = rr * 64 + cc * 2; return st * 1024 + (ob ^ (((ob >> 9) & 1) << 5)); }
__host__ __device__ __forceinline__ void stage_rc(int b, int& R, int& C) { const int st = b / 1024, sb = b % 1024, swz = sb ^ (((sb >> 9) & 1) << 5); R = (st >> 1) * 16 + swz / 64; C = (st & 1) * 32 + (swz % 64) / 2; }
__host__ __device__ __forceinline__ int perm32(int rho) { const int n = rho >> 4, i = rho & 15; return 8 * (i >> 2) + 4 * n + (i & 3); }

struct Unit { int pm, pn; };
struct Gemm { const bf16_t* A; const bf16_t* Bt; int M, N, K; };

struct StaticOrder {
    int nM, nN, nwg, G, c;
    __host__ __device__ void init(int M, int N, int G_, int c_) { nM = M / BM; nN = N / BM; nwg = nM * nN; G = G_; c = c_; }
    __host__ __device__ bool next(int i, Unit& u) const {
        const long L = (long)i * G + c; if (L >= nwg) return false;
        int wgid = (int)L; { const int q = nwg / NXCD, r = nwg % NXCD, xcd = wgid % NXCD, off = wgid / NXCD; wgid = (xcd < r ? xcd * (q + 1) : r * (q + 1) + (xcd - r) * q) + off; }
        const int nig = WGM * nN, gid = wgid / nig, fm = gid * WGM, gsz = (nM - fm) < WGM ? (nM - fm) : WGM;
        u.pm = fm + ((wgid % nig) % gsz); u.pn = (wgid % nig) / gsz; return true;
    }
    __device__ __forceinline__ void a_ready(const Unit&) const {}
    __device__ __forceinline__ void done(const Unit&) const {}
};
__device__ __forceinline__ unsigned cvt_pk_bf16(float lo, float hi) { unsigned r; asm volatile("v_cvt_pk_bf16_f32 %0, %1, %2" : "=v"(r) : "v"(lo), "v"(hi)); return r; }


template <class Epi, class Sched, bool STAMP = false>
__device__ __forceinline__ void gemm_phase(PG8_LAS unsigned char* lds, const Gemm g, const Sched& S, const Epi& E, unsigned long long* stamps) {
    const int tid = threadIdx.x, wid = __builtin_amdgcn_readfirstlane(tid >> 6), lane = tid & 63, wr = wid >> 2, wc = wid & 3, fr = lane & 15, fq = lane >> 4;
    const int K = g.K, nt = K / BK;
    int ts_lo = 0, ts_hi = 0, nts = 0; const unsigned long long rt_entry = STAMP ? (unsigned long long)wall_clock64() : 0ull;
#define PG8_STAMP() do { if (STAMP && wid == 0 && nts < 64) { const unsigned long long _c = (unsigned long long)clock64(); \
        ts_lo = (lane == nts) ? (int)(unsigned)_c : ts_lo; ts_hi = (lane == nts) ? (int)(unsigned)(_c >> 32) : ts_hi; ++nts; } } while (0)
    PG8_STAMP();
    unsigned voffA[2], voffB[2];
#pragma unroll
    for (int i = 0; i < 2; ++i) { int R, C; stage_rc(tid * 16 + i * 8192, R, C); const int Rb = Epi::PERM ? ((R & ~31) + perm32(R & 31)) : R;
        voffA[i] = (unsigned)(R * K + C) * 2u; voffB[i] = (unsigned)(Rb * K + C) * 2u; }
    const size_t kstep = (size_t)(BK * 2);
    const size_t hstep = (size_t)HALF * K * 2;
    const size_t tstep = 2 * hstep;
    const unsigned ldsw = (unsigned)wid * 1024u;
    const int aoff = lds_byte(wr * 64 + fr, fq * 8), boff = lds_byte(wc * 32 + fr, fq * 8);
#define PG8_SA(b, h) (((b) * 2 + (h)) * HTB)
#define PG8_SB(b, h) ((4 + (b) * 2 + (h)) * HTB)
#define PG8_STAGE(bufoff, gbase, voff) do { _Pragma("unroll") for (int _i = 0; _i < 2; ++_i) \
        __builtin_amdgcn_global_load_lds((const unsigned*)((const char*)(gbase) + (voff)[_i]), (PG8_LAS unsigned*)(lds + (bufoff) + ldsw + _i * 8192), 16, 0, 0); } while (0)
#define PG8_LDA(dst, b, h) do { _Pragma("unroll") for (int m = 0; m < 4; ++m) _Pragma("unroll") for (int k = 0; k < 2; ++k) dst[m][k] = *(const PG8_LAS bf16x8*)(lds + PG8_SA(b, h) + aoff + m * 2048 + k * 1024); } while (0)
#define PG8_LDB(dst, b, h) do { _Pragma("unroll") for (int n = 0; n < 2; ++n) _Pragma("unroll") for (int k = 0; k < 2; ++k) dst[n][k] = *(const PG8_LAS bf16x8*)(lds + PG8_SB(b, h) + boff + n * 2048 + k * 1024); } while (0)
#define PG8_MMA(ai, bj, At, Bt) do { __builtin_amdgcn_s_setprio(1); _Pragma("unroll") for (int m = 0; m < 4; ++m) _Pragma("unroll") for (int n = 0; n < 2; ++n) _Pragma("unroll") for (int k = 0; k < 2; ++k) \
        acc[ai][bj][m][n] = __builtin_amdgcn_mfma_f32_16x16x32_bf16(Bt[n][k], At[m][k], acc[ai][bj][m][n], 0, 0, 0); __builtin_amdgcn_s_setprio(0); } while (0)
#define PG8_WAIT_V(n) asm volatile("s_waitcnt vmcnt(" #n ")" ::: "memory")
#define PG8_WAIT_L(n) asm volatile("s_waitcnt lgkmcnt(" #n ")" ::: "memory")
#define PG8_BAR __builtin_amdgcn_s_barrier()
#define PG8_SCHED __builtin_amdgcn_sched_barrier(0)
    Unit cur, nxt; int ui = 0;
    if (!S.next(0, cur)) return;
    f32x4 acc[2][2][4][2];
#pragma unroll
    for (int a = 0; a < 2; ++a)
#pragma unroll
        for (int b = 0; b < 2; ++b)
#pragma unroll
            for (int m = 0; m < 4; ++m)
#pragma unroll
                for (int n = 0; n < 2; ++n) acc[a][b][m][n] = (f32x4){0.f, 0.f, 0.f, 0.f};
    bf16x8 At[4][2], B0[2][2], B1[2][2];
    const char* cA = (const char*)g.A + (size_t)cur.pm * tstep; const char* cB = (const char*)g.Bt + (size_t)cur.pn * tstep;
    S.a_ready(cur);
    PG8_STAGE(PG8_SB(0, 0), cB, voffB); PG8_STAGE(PG8_SA(0, 0), cA, voffA); PG8_STAGE(PG8_SB(0, 1), cB + hstep, voffB); PG8_STAGE(PG8_SA(0, 1), cA + hstep, voffA);
    if (wr == 1) PG8_BAR;
    PG8_WAIT_V(4); PG8_BAR;
    PG8_STAGE(PG8_SB(1, 0), cB + kstep, voffB); PG8_STAGE(PG8_SA(1, 0), cA + kstep, voffA); PG8_STAGE(PG8_SB(1, 1), cB + hstep + kstep, voffB);
    PG8_WAIT_V(6); PG8_BAR;
    PG8_STAMP();
    for (;;) {
        const bool has_next = S.next(ui + 1, nxt);
        const char* nA = has_next ? (const char*)g.A + (size_t)nxt.pm * tstep : cA; const char* nB = has_next ? (const char*)g.Bt + (size_t)nxt.pn * tstep : cB;
        for (int t = 0; t < nt; t += 2) {
            const bool last = (t == nt - 2);
            const char* a1 = cA + (size_t)(t + 1) * kstep;
            const char* a2 = last ? nA : cA + (size_t)(t + 2) * kstep; const char* b2 = last ? nB : cB + (size_t)(t + 2) * kstep;
            const char* a3 = a2 + kstep; const char* b3 = b2 + kstep;
            if (last && has_next) S.a_ready(nxt);
            PG8_LDB(B0, 0, 0); PG8_SCHED; PG8_LDA(At, 0, 0); PG8_STAGE(PG8_SA(1, 1), a1 + hstep, voffA);
            PG8_WAIT_L(8); PG8_BAR; PG8_WAIT_L(0); PG8_MMA(0, 0, At, B0); PG8_BAR; PG8_SCHED;
            PG8_LDB(B1, 0, 1); PG8_STAGE(PG8_SB(0, 0), b2, voffB);
            PG8_BAR; PG8_WAIT_L(0); PG8_MMA(0, 1, At, B1); PG8_BAR;
            PG8_LDA(At, 0, 1); PG8_STAGE(PG8_SA(0, 0), a2, voffA);
            PG8_BAR; PG8_WAIT_L(0); PG8_MMA(1, 0, At, B0); PG8_BAR; PG8_SCHED;
            PG8_STAGE(PG8_SB(0, 1), b2 + hstep, voffB);
            PG8_WAIT_V(6); PG8_BAR; PG8_MMA(1, 1, At, B1); PG8_BAR;
            PG8_LDB(B0, 1, 0); PG8_SCHED; PG8_LDA(At, 1, 0); PG8_STAGE(PG8_SA(0, 1), a2 + hstep, voffA);
            PG8_WAIT_L(8); PG8_BAR; PG8_WAIT_L(0); PG8_MMA(0, 0, At, B0); PG8_BAR; PG8_SCHED;
            PG8_LDB(B1, 1, 1); PG8_STAGE(PG8_SB(1, 0), b3, voffB);
            PG8_BAR; PG8_WAIT_L(0); PG8_MMA(0, 1, At, B1); PG8_BAR;
            PG8_LDA(At, 1, 1); PG8_STAGE(PG8_SA(1, 0), a3, voffA);
            PG8_BAR; PG8_WAIT_L(0); PG8_MMA(1, 0, At, B0); PG8_BAR; PG8_SCHED;
            PG8_STAGE(PG8_SB(1, 1), b3 + hstep, voffB);
            PG8_WAIT_V(6); PG8_BAR; PG8_MMA(1, 1, At, B1); PG8_BAR;
        }
        PG8_STAMP();
        if constexpr (!Epi::AFTER_DRAIN) { E(acc, cur, wr, wc, fr, fq); S.done(cur); }
        PG8_STAMP();
        if (!has_next) break;
#pragma unroll
        for (int a = 0; a < 2; ++a)
#pragma unroll
            for (int b = 0; b < 2; ++b)
#pragma unroll
                for (int m = 0; m < 4; ++m)
#pragma unroll
                    for (int n = 0; n < 2; ++n) acc[a][b][m][n] = (f32x4){0.f, 0.f, 0.f, 0.f};
        cur = nxt; cA = nA; cB = nB; ++ui;
    }
    PG8_WAIT_V(0);
    if (wr == 0) PG8_BAR;
    PG8_BAR;
    if constexpr (Epi::AFTER_DRAIN) { E.fused(acc, cur, wr, wc, fr, fq, lds, wid, lane); S.done(cur); }
    PG8_STAMP();
    if (STAMP && wid == 0) { stamps[lane] = lane < nts ? (((unsigned long long)(unsigned)ts_hi << 32) | (unsigned)ts_lo) : 0ull;
        if (lane == 62) stamps[62] = rt_entry; if (lane == 63) stamps[63] = (unsigned long long)wall_clock64(); }
#undef PG8_STAMP
#undef PG8_SA
#undef PG8_SB
#undef PG8_STAGE
#undef PG8_LDA
#undef PG8_LDB
#undef PG8_MMA
#undef PG8_WAIT_V
#undef PG8_WAIT_L
#undef PG8_BAR
#undef PG8_SCHED
}
}
using namespace pg8;
typedef float f32x16 __attribute__((ext_vector_type(16)));
typedef short s16x4 __attribute__((ext_vector_type(4)));
typedef unsigned u32x2 __attribute__((ext_vector_type(2)));

__device__ __forceinline__ float bf2f(bf16_t x) { return __uint_as_float(((unsigned)x) << 16); }
__device__ __forceinline__ bf16_t f2bf(float f) { unsigned u = __float_as_uint(f); u += 0x7FFFu + ((u >> 16) & 1u); return (bf16_t)(u >> 16); }
__device__ __forceinline__ float wave_sum(float v) {
#pragma unroll
    for (int o = 32; o > 0; o >>= 1) v += __shfl_xor(v, o);
    return v;
}
__device__ __forceinline__ float siluf(float a) { return a / (1.f + __expf(-a)); }

struct EpiU {
    static constexpr bool PERM = true, AFTER_DRAIN = false;
    bf16_t* O; int ldc;
    __device__ __forceinline__ void operator()(const f32x4 (&acc)[2][2][4][2], const Unit& u, int wr, int wc, int fr, int fq) const {
        const int row0 = u.pm * BM + wr * 64 + fr, col0 = u.pn * BM + wc * 32 + 8 * fq;
#pragma unroll
        for (int ai = 0; ai < 2; ++ai)
#pragma unroll
            for (int m = 0; m < 4; ++m) { bf16_t* rowp = O + (size_t)(row0 + ai * HALF + m * 16) * ldc + col0;
#pragma unroll
                for (int bj = 0; bj < 2; ++bj) { const f32x4 v0 = acc[ai][bj][m][0], v1 = acc[ai][bj][m][1];
                    u32x4 w = {cvt_pk_bf16(v0[0], v0[1]), cvt_pk_bf16(v0[2], v0[3]), cvt_pk_bf16(v1[0], v1[1]), cvt_pk_bf16(v1[2], v1[3])};
                    *(u32x4*)(rowp + bj * HALF) = w; } }
    }
};
struct EpiRes {
    static constexpr bool PERM = false, AFTER_DRAIN = false;
    float* Y; const float* xp; const float* xs; const float* mod;
    __device__ __forceinline__ void operator()(const f32x4 (&acc)[2][2][4][2], const Unit& u, int wr, int wc, int fr, int fq) const {
        const int row0 = u.pm * BM + wr * 64 + fr, col0 = u.pn * BM + wc * 32 + 4 * fq;
        const bool prompt = u.pm < 16; const int j = prompt ? 0 : 1 + ((u.pm - 16) >> 3);
        const float* gp = mod + j * 6144 + 4096 + col0;
        f32x4 gv[2][2];
#pragma unroll
        for (int bj = 0; bj < 2; ++bj)
#pragma unroll
            for (int n = 0; n < 2; ++n) gv[bj][n] = *(const f32x4*)(gp + bj * HALF + n * 16);
#pragma unroll
        for (int ai = 0; ai < 2; ++ai)
#pragma unroll
            for (int m = 0; m < 4; ++m) { const int r = row0 + ai * HALF + m * 16;
                const float* bp = (prompt ? xp + (size_t)r * 2048 : xs + (size_t)(r - NPTOK) * 2048) + col0; float* yp = Y + (size_t)r * 2048 + col0;
#pragma unroll
                for (int bj = 0; bj < 2; ++bj)
#pragma unroll
                    for (int n = 0; n < 2; ++n) { const f32x4 x = *(const f32x4*)(bp + bj * HALF + n * 16);
                        *(f32x4*)(yp + bj * HALF + n * 16) = x + gv[bj][n] * acc[ai][bj][m][n]; } }
    }
};

constexpr int QBLK = 32, KVBLK = 64;
constexpr float SCALE = 0.088388347648318440f;
constexpr float THR = 8.f;
constexpr size_t SHM_V = KVBLK * 128 * 2, SHM_K = KVBLK * 128 * 2;
constexpr int Q_LDS_OFF = 2 * 16384 + 2 * 16384 + 8 * 64 * 4;
#define KSWZ(row, colB) ((row) * 256 + ((colB) ^ (((row) & 7) << 4)))
#define SBAR() __builtin_amdgcn_sched_barrier(0)
__device__ __forceinline__ int crow(int r, int hi) { return (r & 3) + 8 * (r >> 2) + 4 * hi; }

__device__ __forceinline__ void partialSM(f32x16& p0, f32x16& p1, float& m_reg, float& mn, float& alpha, bool domask, int kd, int hi) {
  constexpr float C = SCALE * 1.4426950408889634f;
  if (domask) {
#pragma unroll
    for (int r = 0; r < 16; ++r) { const int kk = kd + crow(r, hi); p0[r] = (kk >= -128 && kk <= 128) ? p0[r] : -1e30f; p1[r] = (kk + 32 >= -128 && kk + 32 <= 128) ? p1[r] : -1e30f; }
  }
  float pmax = p0[0];
#pragma unroll
  for (int r = 1; r < 16; ++r) pmax = fmaxf(pmax, p0[r]);
#pragma unroll
  for (int r = 0; r < 16; ++r) pmax = fmaxf(pmax, p1[r]);
  { auto rr = __builtin_amdgcn_permlane32_swap(__float_as_uint(pmax), __float_as_uint(pmax), false, false);
    pmax = fmaxf(__uint_as_float(rr[0]), __uint_as_float(rr[1])); }
  if (__builtin_expect(__all(pmax - m_reg <= THR / SCALE), 1)) { mn = m_reg; alpha = 1.f; }
  else { mn = fmaxf(m_reg, pmax); alpha = __builtin_amdgcn_exp2f((m_reg - mn) * C); m_reg = mn; }
  float mnC = -mn * C;
#pragma unroll
  for (int r = 0; r < 16; ++r) p0[r] = fmaf(p0[r], C, mnC);
#pragma unroll
  for (int r = 0; r < 16; ++r) p1[r] = fmaf(p1[r], C, mnC);
#pragma unroll
  for (int r = 0; r < 16; ++r) p0[r] = __builtin_amdgcn_exp2f(p0[r]);
}
__device__ __forceinline__ void finishSM(f32x16& p0, f32x16& p1, float alpha, float& l_reg, bf16x8& pa0, bf16x8& pa1, bf16x8& pa2, bf16x8& pa3) {
#pragma unroll
  for (int r = 0; r < 16; ++r) p1[r] = __builtin_amdgcn_exp2f(p1[r]);
  float ps = 0;
#pragma unroll
  for (int r = 0; r < 16; ++r) ps += p0[r];
#pragma unroll
  for (int r = 0; r < 16; ++r) ps += p1[r];
  { auto rr = __builtin_amdgcn_permlane32_swap(__float_as_uint(ps), __float_as_uint(ps), false, false);
    ps = __uint_as_float(rr[0]) + __uint_as_float(rr[1]); }
  l_reg = l_reg * alpha + ps;
#define PK4(P, BASE, OUT) do { unsigned a0 = cvt_pk_bf16(P[BASE + 0], P[BASE + 1]), a1 = cvt_pk_bf16(P[BASE + 2], P[BASE + 3]);   \
    unsigned b0 = cvt_pk_bf16(P[BASE + 4], P[BASE + 5]), b1 = cvt_pk_bf16(P[BASE + 6], P[BASE + 7]);                              \
    auto r0 = __builtin_amdgcn_permlane32_swap(a0, b0, false, false); auto r1 = __builtin_amdgcn_permlane32_swap(a1, b1, false, false); \
    u32x4 w = {r0[0], r1[0], r0[1], r1[1]}; OUT = *reinterpret_cast<bf16x8*>(&w); } while (0)
  PK4(p0, 0, pa0); PK4(p0, 8, pa1); PK4(p1, 0, pa2); PK4(p1, 8, pa3);
#undef PK4
}
__device__ __forceinline__ void qkt(f32x16& p0, f32x16& p1, const bf16_t* Ks, const char* qrow, int r32, int hi) {
  p0 = f32x16{}; p1 = f32x16{};
#pragma unroll
  for (int d0 = 0; d0 < 8; ++d0) { int cb = (d0 * 16 + hi * 8) * 2;
    const bf16x8 qf = *reinterpret_cast<const bf16x8*>(qrow + (cb ^ ((r32 & 7) << 4)));
    bf16x8 b0 = *reinterpret_cast<const bf16x8*>((const char*)Ks + KSWZ(r32, cb));
    bf16x8 b1 = *reinterpret_cast<const bf16x8*>((const char*)Ks + KSWZ(32 + r32, cb));
    p0 = __builtin_amdgcn_mfma_f32_32x32x16_bf16(b0, qf, p0, 0, 0, 0);
    p1 = __builtin_amdgcn_mfma_f32_32x32x16_bf16(b1, qf, p1, 0, 0, 0); }
}
__device__ __forceinline__ int v_st(int k, int c) { const int kk = (k & ~0xC) | ((k & 4) << 1) | ((k & 8) >> 1); return ((kk >> 3) * 4 + (c >> 5)) * 512 + ((kk & 7) * 32 + (c & 31)) * 2; }
__device__ __forceinline__ int v_rd_base(int lane) { return ((lane & 3) << 3) | (((lane >> 2) & 3) << 6) | (((lane >> 4) & 1) << 5) | (((lane >> 5) & 1) << 8); }
constexpr int v_rd_off(int d0, int ks, int half) { return d0 * 512 + ks * 4096 + half * 2048; }
template <int OFF> __device__ __forceinline__ s16x4 tr_read(int vb) {
  s16x4 r; asm volatile("ds_read_b64_tr_b16 %0, %1 offset:%2" : "=&v"(r) : "v"(vb), "i"(OFF) : "memory"); return r;
}
template <int D0> __device__ __forceinline__ void pv_one(f32x16& od, int vb, bf16x8 pa0, bf16x8 pa1, bf16x8 pa2, bf16x8 pa3) {
  const s16x4 l0 = tr_read<v_rd_off(D0, 0, 0)>(vb), h0 = tr_read<v_rd_off(D0, 0, 1)>(vb), l1 = tr_read<v_rd_off(D0, 1, 0)>(vb), h1 = tr_read<v_rd_off(D0, 1, 1)>(vb);
  const s16x4 l2 = tr_read<v_rd_off(D0, 2, 0)>(vb), h2 = tr_read<v_rd_off(D0, 2, 1)>(vb), l3 = tr_read<v_rd_off(D0, 3, 0)>(vb), h3 = tr_read<v_rd_off(D0, 3, 1)>(vb);
  asm volatile("s_waitcnt lgkmcnt(0)" ::: "memory"); SBAR();
#define PK(L, H) (bf16x8){L[0], L[1], L[2], L[3], H[0], H[1], H[2], H[3]}
  od = __builtin_amdgcn_mfma_f32_32x32x16_bf16(pa0, PK(l0, h0), od, 0, 0, 0);
  od = __builtin_amdgcn_mfma_f32_32x32x16_bf16(pa1, PK(l1, h1), od, 0, 0, 0);
  od = __builtin_amdgcn_mfma_f32_32x32x16_bf16(pa2, PK(l2, h2), od, 0, 0, 0);
  od = __builtin_amdgcn_mfma_f32_32x32x16_bf16(pa3, PK(l3, h3), od, 0, 0, 0);
#undef PK
}
__device__ __forceinline__ void pv_d0(f32x16* o, int vb, bf16x8 pa0, bf16x8 pa1, bf16x8 pa2, bf16x8 pa3) {
  pv_one<0>(o[0], vb, pa0, pa1, pa2, pa3); pv_one<1>(o[1], vb, pa0, pa1, pa2, pa3); pv_one<2>(o[2], vb, pa0, pa1, pa2, pa3); pv_one<3>(o[3], vb, pa0, pa1, pa2, pa3);
}

template <int LDQ>
__device__ __forceinline__ void attn_body(const bf16_t* __restrict__ Qb, const bf16_t* __restrict__ Kh, const bf16_t* __restrict__ Vh,
                                          const bf16_t* __restrict__ Gb, bf16_t* __restrict__ Ob, const int NT, const int nctx, const int ctx_base,
                                          const int lat_start, const bool window, const int i0, const bool has_sink, const float sink, char* lds) {
  constexpr int LDK = 128;
  int tid_ = threadIdx.x; asm volatile("" : "+v"(tid_));
  const int tid = tid_, wid = __builtin_amdgcn_readfirstlane(tid >> 6), lane = tid & 63, r32 = lane & 31, hi = lane >> 5;
  bf16_t* V_lds = (bf16_t*)lds; bf16_t* K_lds = (bf16_t*)(lds + 2 * SHM_V);
  float* ws = (float*)(lds + 2 * SHM_V + 2 * SHM_K) + wid * 64; float* li_l = ws; float* al_l = ws + 32;
  float m_reg = -1e30f, l_reg = 0; f32x16 o[4] = {};
  char* qrow = lds + Q_LDS_OFF + (wid * QBLK + r32) * 256;
  { const bf16_t* Qw = Qb + (long)(wid * QBLK + r32) * LDQ + hi * 8;
#pragma unroll
    for (int d0 = 0; d0 < 8; ++d0) { const bf16x8 t = *reinterpret_cast<const bf16x8*>(Qw + d0 * 16); *reinterpret_cast<bf16x8*>(qrow + (((d0 * 16 + hi * 8) * 2) ^ ((r32 & 7) << 4))) = t; }
    asm volatile("s_waitcnt lgkmcnt(0)" ::: "memory"); }
  const int sr = tid >> 4, sc = (tid & 15) * 8, vst0 = v_st(sr, sc), vst1 = v_st(32 + sr, sc);
  const int vb0 = (int)(uintptr_t)V_lds + v_rd_base(lane);
  const int qpos = i0 + wid * 32 + r32, qw = i0 + wid * 32;
  struct { bf16x8 vs0, vs1, ks0, ks1; } sr_[2];
#define KOFF(j) ((j) < nctx ? ctx_base + (j) * 64 : (lat_start + (j) - nctx) * 64)
#define DOMASK(j, k0) (window && (j) >= nctx && !(((k0) + 63 - qw <= 128) && (qw + 31 - (k0) <= 128)))
#define SLOAD(i, k0) do { sr_[i].vs0 = *(const bf16x8*)(&Vh[(long)((k0) + sr) * LDK + sc]); sr_[i].vs1 = *(const bf16x8*)(&Vh[(long)((k0) + 32 + sr) * LDK + sc]); \
    sr_[i].ks0 = *(const bf16x8*)(&Kh[(long)((k0) + sr) * LDK + sc]); sr_[i].ks1 = *(const bf16x8*)(&Kh[(long)((k0) + 32 + sr) * LDK + sc]); } while (0)
#define SWRITE(b, i) do { *(bf16x8*)((char*)V_lds + (b) * SHM_V + vst0) = sr_[i].vs0;          \
    *(bf16x8*)((char*)V_lds + (b) * SHM_V + vst1) = sr_[i].vs1; int kc = sc * 2;               \
    *(bf16x8*)((char*)K_lds + (b) * SHM_K + KSWZ(sr, kc)) = sr_[i].ks0;                       \
    *(bf16x8*)((char*)K_lds + (b) * SHM_K + KSWZ(32 + sr, kc)) = sr_[i].ks1; } while (0)
#define SWAIT() asm volatile("s_waitcnt vmcnt(4)" ::: "memory")
#define RESC(a) do { if (__any((a) < 1.f)) { if (hi == 0) al_l[r32] = (a); asm volatile("s_waitcnt lgkmcnt(0)" ::: "memory"); \
    _Pragma("unroll") for (int d = 0; d < 4; ++d) _Pragma("unroll") for (int r = 0; r < 16; ++r) o[d][r] *= al_l[crow(r, hi)]; } } while (0)
  f32x16 pA0, pA1, pB0, pB1; float mnA, mnB, alA, alB; bf16x8 pa0, pa1, pa2, pa3;
  constexpr int SE = 0, SO = 1;
  int kcur = KOFF(0);
  SLOAD(SE, kcur); asm volatile("s_waitcnt vmcnt(0)" ::: "memory"); SWRITE(0, SE); __syncthreads();
  qkt(pA0, pA1, K_lds, qrow, r32, hi); partialSM(pA0, pA1, m_reg, mnA, alA, DOMASK(0, kcur), kcur - qpos, hi);
  { const int k1 = KOFF(1); SLOAD(SO, k1); } if (2 < NT) { const int k2 = KOFF(2); SLOAD(SE, k2); }
  SWAIT(); SWRITE(1, SO); __syncthreads();
  for (int j = 1; j + 1 < NT; j += 2) {
    SBAR(); qkt(pB0, pB1, (bf16_t*)((char*)K_lds + SHM_K), qrow, r32, hi);
    finishSM(pA0, pA1, alA, l_reg, pa0, pa1, pa2, pa3); SBAR();
    { const int kn = KOFF(j + 2); SLOAD(SO, kn); } SBAR();
    { const int kj = KOFF(j); pv_d0(o, vb0, pa0, pa1, pa2, pa3); partialSM(pB0, pB1, m_reg, mnB, alB, DOMASK(j, kj), kj - qpos, hi); }
    __syncthreads(); SWAIT(); SWRITE(0, SE);
    RESC(alB); __syncthreads();
    SBAR(); qkt(pA0, pA1, K_lds, qrow, r32, hi);
    finishSM(pB0, pB1, alB, l_reg, pa0, pa1, pa2, pa3); SBAR();
    if (j + 3 < NT) { const int kn = KOFF(j + 3); SLOAD(SE, kn); } SBAR();
    { const int kj = KOFF(j + 1); pv_d0(o, vb0 + (int)SHM_V, pa0, pa1, pa2, pa3); partialSM(pA0, pA1, m_reg, mnA, alA, DOMASK(j + 1, kj), kj - qpos, hi); }
    __syncthreads(); SWAIT(); SWRITE(1, SO);
    RESC(alA); __syncthreads();
  }
  SBAR(); qkt(pB0, pB1, (bf16_t*)((char*)K_lds + SHM_K), qrow, r32, hi);
  finishSM(pA0, pA1, alA, l_reg, pa0, pa1, pa2, pa3); SBAR();
  { const int kj = KOFF(NT - 1); pv_d0(o, vb0, pa0, pa1, pa2, pa3); partialSM(pB0, pB1, m_reg, mnB, alB, DOMASK(NT - 1, kj), kj - qpos, hi); }
  __syncthreads(); RESC(alB);
  finishSM(pB0, pB1, alB, l_reg, pa0, pa1, pa2, pa3); SBAR();
  pv_d0(o, vb0 + (int)SHM_V, pa0, pa1, pa2, pa3);
  if (has_sink) l_reg += __builtin_amdgcn_exp2f(sink * 1.4426950408889634f - m_reg * (SCALE * 1.4426950408889634f));
  if (hi == 0) li_l[r32] = l_reg; asm volatile("s_waitcnt lgkmcnt(0)" ::: "memory");
  const bf16_t* Gw = Gb + (long)(wid * QBLK) * LDQ; bf16_t* Ow = Ob + (long)(wid * QBLK) * 2048;
#pragma unroll
  for (int r = 0; r < 16; ++r) { const int orow = crow(r, hi); const float rl = __builtin_amdgcn_rcpf(li_l[orow]);
#pragma unroll
    for (int d0 = 0; d0 < 4; ++d0) { const float gg = bf2f(Gw[(long)orow * LDQ + d0 * 32 + r32]);
      Ow[(long)orow * 2048 + d0 * 32 + r32] = f2bf(o[d0][r] * rl * siluf(gg)); } }
#undef SLOAD
#undef SWRITE
#undef SWAIT
#undef RESC
#undef KOFF
#undef DOMASK
}

#define MFMA16(a, b, c) __builtin_amdgcn_mfma_f32_16x16x32_bf16((a), (b), (c), 0, 0, 0)
__device__ __forceinline__ bf16x8 as_bf8(u32x4 w) { return *reinterpret_cast<bf16x8*>(&w); }
__device__ __forceinline__ void hgrn_chain(const Params& p, char* lds, int item) {
    int tid_ = threadIdx.x; asm volatile("" : "+v"(tid_));
    const int tid = tid_, wid = __builtin_amdgcn_readfirstlane(tid >> 6), lane = tid & 63, l16 = lane & 15, g = lane >> 4;
    const bool samp = item < 128; const int it = samp ? item : item - 128;
    const int b = it >> 4, h = (it >> 1) & 7, dir = it & 1;
    const int L = samp ? 2048 : 256; const long tok0 = samp ? NPTOK + (long)b * 2048 : (long)b * 256;
    const int nchunk = L >> 5;
    bf16_t* U = (bf16_t*)(p.ws + WS_U);
    const int d = tid & 127, part = tid >> 7;
    const float lbv = ((const float*)(p.ws + WS_LB))[dir * 1024 + h * 128 + d];
    bf16_t* qd = (bf16_t*)lds;
    bf16_t* ki = qd + 32 * 136;
    bf16_t* keT = ki + 32 * 136;
    bf16_t* vT = keT + 128 * 40;
    float* dec = (float*)(vT + 128 * 40);
    float* tot = dec + 128;
    f32x4 S[8];
    if (samp) { const float* st = p.in[2] + (size_t)((b * 2 + dir) * 8 + h) * 16384;
#pragma unroll
        for (int m = 0; m < 8; ++m)
#pragma unroll
            for (int i = 0; i < 4; ++i) S[m][i] = st[(16 * m + 4 * g + i) * 128 + 16 * wid + l16];
    } else {
#pragma unroll
        for (int m = 0; m < 8; ++m) S[m] = (f32x4){0.f, 0.f, 0.f, 0.f};
    }
    const bf16_t* ubase = U + h * 128 + d;
    const int gcol = 1024 * (1 + dir);
    bf16_t raq[8], raf[8], rai[8];
#define HLD(c) do { _Pragma("unroll") for (int tt = 0; tt < 8; ++tt) { const int i_ = (c) * 32 + part * 8 + tt; const int tk_ = dir ? (L - 1 - i_) : i_; \
        const bf16_t* u_ = ubase + (size_t)(tok0 + tk_) * LDU0; raq[tt] = u_[0]; raf[tt] = u_[gcol]; rai[tt] = u_[3072]; } } while (0)
    HLD(0);
    __syncthreads();
    for (int c = 0; c < nchunk; ++c) {
        float q[8], k[8], bl[8]; unsigned vv[4];
        float cum = 0.f;
#pragma unroll
        for (int tt = 0; tt < 8; ++tt) { q[tt] = siluf(bf2f(raq[tt])); const float sg = 1.f / (1.f + __expf(-bf2f(raf[tt])));
            const float f = lbv + (1.f - lbv) * sg; k[tt] = 1.f - f; cum += __logf(f); bl[tt] = cum; }
#pragma unroll
        for (int tt = 0; tt < 4; ++tt) vv[tt] = (unsigned)rai[2 * tt] | ((unsigned)rai[2 * tt + 1] << 16);
        tot[part * 128 + d] = cum;
        if (c + 1 < nchunk) HLD(c + 1);
        __syncthreads();
        float off = 0.f, blast = 0.f;
#pragma unroll
        for (int pp = 0; pp < 4; ++pp) { const float tv = tot[pp * 128 + d]; blast += tv; off += (pp < part) ? tv : 0.f; }
        float ke[8];
#pragma unroll
        for (int tt = 0; tt < 8; ++tt) { const float bb = off + bl[tt]; const int t = part * 8 + tt;
            qd[t * 136 + d] = f2bf(q[tt] * __expf(bb)); ki[t * 136 + d] = f2bf(k[tt] * __expf(-bb)); ke[tt] = k[tt] * __expf(blast - bb); }
        { u32x4 w = {cvt_pk_bf16(ke[0], ke[1]), cvt_pk_bf16(ke[2], ke[3]), cvt_pk_bf16(ke[4], ke[5]), cvt_pk_bf16(ke[6], ke[7])};
          *(u32x4*)(keT + d * 40 + part * 8) = w; u32x4 w2 = {vv[0], vv[1], vv[2], vv[3]}; *(u32x4*)(vT + d * 40 + part * 8) = w2; }
        if (part == 0) dec[d] = __expf(blast);
        __syncthreads();
        f32x4 T00 = {0.f, 0.f, 0.f, 0.f}, T01 = T00, T11 = T00;
#pragma unroll
        for (int ks = 0; ks < 4; ++ks) {
            const bf16x8 a0 = *(const bf16x8*)(ki + l16 * 136 + 32 * ks + 8 * g), a1 = *(const bf16x8*)(ki + (16 + l16) * 136 + 32 * ks + 8 * g);
            const bf16x8 b0 = *(const bf16x8*)(qd + l16 * 136 + 32 * ks + 8 * g), b1 = *(const bf16x8*)(qd + (16 + l16) * 136 + 32 * ks + 8 * g);
            T00 = MFMA16(a0, b0, T00); T01 = MFMA16(a0, b1, T01); T11 = MFMA16(a1, b1, T11);
        }
#pragma unroll
        for (int i = 0; i < 4; ++i) if (4 * g + i > l16) { T00[i] = 0.f; T11[i] = 0.f; }
        const u32x4 P0w = {cvt_pk_bf16(T00[0], T00[1]), cvt_pk_bf16(T00[2], T00[3]), 0u, 0u};
        const u32x4 P1w = {cvt_pk_bf16(T01[0], T01[1]), cvt_pk_bf16(T01[2], T01[3]), cvt_pk_bf16(T11[0], T11[1]), cvt_pk_bf16(T11[2], T11[3])};
        const bf16_t* vrow = vT + (16 * wid + l16) * 40;
        const u32x2 vlo = *(const u32x2*)(vrow + 4 * g), vhi = *(const u32x2*)(vrow + 16 + 4 * g);
        const u32x4 Bvw = {vlo[0], vlo[1], vhi[0], vhi[1]};
        f32x4 o0 = {0.f, 0.f, 0.f, 0.f}, o1 = o0;
        o0 = MFMA16(as_bf8(P0w), as_bf8(Bvw), o0); o1 = MFMA16(as_bf8(P1w), as_bf8(Bvw), o1);
#pragma unroll
        for (int ks = 0; ks < 4; ++ks) {
            const u32x2 x0 = *(const u32x2*)(qd + l16 * 136 + 32 * ks + 4 * g), x1 = *(const u32x2*)(qd + l16 * 136 + 32 * ks + 16 + 4 * g);
            const u32x2 y0 = *(const u32x2*)(qd + (16 + l16) * 136 + 32 * ks + 4 * g), y1 = *(const u32x2*)(qd + (16 + l16) * 136 + 32 * ks + 16 + 4 * g);
            const u32x4 A0w = {x0[0], x0[1], x1[0], x1[1]}, A1w = {y0[0], y0[1], y1[0], y1[1]};
            const u32x4 Bsw = {cvt_pk_bf16(S[2 * ks][0], S[2 * ks][1]), cvt_pk_bf16(S[2 * ks][2], S[2 * ks][3]),
                               cvt_pk_bf16(S[2 * ks + 1][0], S[2 * ks + 1][1]), cvt_pk_bf16(S[2 * ks + 1][2], S[2 * ks + 1][3])};
            o0 = MFMA16(as_bf8(A0w), as_bf8(Bsw), o0); o1 = MFMA16(as_bf8(A1w), as_bf8(Bsw), o1);
        }
        const bf16x8 bvv = *(const bf16x8*)(vrow + 8 * g);
#pragma unroll
        for (int m = 0; m < 8; ++m) { const f32x4 dc = *(const f32x4*)(dec + 16 * m + 4 * g); S[m] = S[m] * dc;
            const bf16x8 a = *(const bf16x8*)(keT + (16 * m + l16) * 40 + 8 * g); S[m] = MFMA16(a, bvv, S[m]); }
#pragma unroll
        for (int i = 0; i < 4; ++i) {
            const int i0_ = c * 32 + 4 * g + i, i1_ = i0_ + 16; const int t0_ = dir ? (L - 1 - i0_) : i0_, t1_ = dir ? (L - 1 - i1_) : i1_;
            U[(size_t)(tok0 + t0_) * LDU0 + gcol + h * 128 + 16 * wid + l16] = f2bf(o0[i]);
            U[(size_t)(tok0 + t1_) * LDU0 + gcol + h * 128 + 16 * wid + l16] = f2bf(o1[i]);
        }
    }
    if (!samp) { float* st = p.out + OUT_STATE + (size_t)((b * 2 + dir) * 8 + h) * 16384;
#pragma unroll
        for (int m = 0; m < 8; ++m)
#pragma unroll
            for (int i = 0; i < 4; ++i) st[(16 * m + 4 * g + i) * 128 + 16 * wid + l16] = S[m][i];
    }
#undef HLD
}

__device__ __forceinline__ void phase_prologue(const Params& p, char* lds) {
    const int tid = threadIdx.x;
    float* sl = (float*)lds;
    float* red = (float*)(lds + 73728);
    for (int idx = tid; idx < 9 * 2048; idx += 512) { const int j = idx >> 11, k = idx & 2047; const float c = j ? p.in[7][(j - 1) * 2048 + k] : p.in[8][k]; sl[idx] = siluf(c); }
    __syncthreads();
    for (int task = blockIdx.x; task < 192; task += gridDim.x) {
        const int layer = task / 96, colg = task % 96, cc = tid & 63, kp = tid >> 6, col = colg * 64 + cc;
        const float* W = p.in[layer ? 19 : 11]; const float* bm = p.in[layer ? 20 : 12];
        float acc[9];
#pragma unroll
        for (int j = 0; j < 9; ++j) acc[j] = 0.f;
#pragma unroll 4
        for (int k = kp * 256; k < kp * 256 + 256; ++k) { const float w = W[(size_t)k * 6144 + col];
#pragma unroll
            for (int j = 0; j < 9; ++j) acc[j] = fmaf(sl[j * 2048 + k], w, acc[j]); }
#pragma unroll
        for (int j = 0; j < 9; ++j) red[(kp * 9 + j) * 64 + cc] = acc[j];
        __syncthreads();
        for (int idx = tid; idx < 576; idx += 512) { const int j = idx >> 6, c2 = idx & 63; float s = 0.f;
#pragma unroll
            for (int q = 0; q < 8; ++q) s += red[(q * 9 + j) * 64 + c2];
            ((float*)(p.ws + WS_MOD))[(layer * 9 + j) * 6144 + colg * 64 + c2] = s + bm[colg * 64 + c2]; }
        __syncthreads();
    }
    if (blockIdx.x == gridDim.x - 1) {
        for (int idx = tid; idx < 2048; idx += 512) { const float g0 = p.in[9][idx], g1 = p.in[9][2048 + idx], g2 = p.in[9][4096 + idx];
            const float m = fmaxf(g0, fmaxf(g1, g2)); const float e0 = __expf(g0 - m), e1 = __expf(g1 - m), e2 = __expf(g2 - m);
            ((float*)(p.ws + WS_LB))[idx] = e0 / (e0 + e1 + e2); }
    }
    bf16_t* T = (bf16_t*)lds;
    for (int t = blockIdx.x; t < 4224; t += gridDim.x) {
        const int ct = t >> 4, kt = t & 15; const float* W; bf16_t* WT; int N, nt;
        if (ct < 120) { W = p.in[13]; WT = (bf16_t*)(p.ws + WS_WT_IN0); N = 7680; nt = ct; }
        else if (ct < 152) { W = p.in[14]; WT = (bf16_t*)(p.ws + WS_WT_OUT0); N = 2048; nt = ct - 120; }
        else if (ct < 232) { W = p.in[21]; WT = (bf16_t*)(p.ws + WS_WT_IN1); N = 5120; nt = ct - 152; }
        else { W = p.in[22]; WT = (bf16_t*)(p.ws + WS_WT_OUT1); N = 2048; nt = ct - 232; }
        const int r = tid >> 4, c4 = (tid & 15) * 4;
#pragma unroll
        for (int itr = 0; itr < 4; ++itr) { const int kk = itr * 32 + r; const f32x4 v = *(const f32x4*)(W + (size_t)(kt * 128 + kk) * N + nt * 64 + c4);
#pragma unroll
            for (int e = 0; e < 4; ++e) T[(c4 + e) * 136 + kk] = f2bf(v[e]); }
        __syncthreads();
        { const int n = tid >> 3, k16 = (tid & 7) * 16; bf16_t* dst = WT + (size_t)(nt * 64 + n) * 2048 + kt * 128 + k16;
          *(u32x4*)dst = *(const u32x4*)(T + n * 136 + k16); *(u32x4*)(dst + 8) = *(const u32x4*)(T + n * 136 + k16 + 8); }
        __syncthreads();
    }
}

__device__ __forceinline__ void phase_norm(const float* xa, const float* xb, const float* g, const float* mod, bf16_t* H) {
    const int lane = threadIdx.x & 63, gw = blockIdx.x * 8 + (threadIdx.x >> 6), nw = gridDim.x * 8;
    for (int row = gw; row < NTOK; row += nw) {
        const float* src = row < NPTOK ? xa + (size_t)row * 2048 : xb + (size_t)(row - NPTOK) * 2048;
        const int j = row < NPTOK ? 0 : 1 + ((row - NPTOK) >> 11);
        f32x4 v[8]; float ss = 0.f;
#pragma unroll
        for (int i = 0; i < 8; ++i) { v[i] = *(const f32x4*)(src + (i * 64 + lane) * 4); ss += v[i][0] * v[i][0] + v[i][1] * v[i][1] + v[i][2] * v[i][2] + v[i][3] * v[i][3]; }
        ss = wave_sum(ss); const float rstd = rsqrtf(ss * (1.f / 2048.f) + 1e-6f);
        const float* sh = mod + j * 6144; const float* sc = sh + 2048;
#pragma unroll
        for (int i = 0; i < 8; ++i) { const int col = (i * 64 + lane) * 4; const f32x4 g4 = *(const f32x4*)(g + col), s4 = *(const f32x4*)(sh + col), c4 = *(const f32x4*)(sc + col);
            const f32x4 y = v[i] * rstd * g4 * (c4 + 1.f) + s4;
            u32x2 w = {cvt_pk_bf16(y[0], y[1]), cvt_pk_bf16(y[2], y[3])}; *(u32x2*)(H + (size_t)row * 2048 + col) = w; }
    }
}

template <int LAYER>
__device__ __forceinline__ void phase_prep(const Params& p) {
    constexpr int LDU = LAYER ? LDU1 : LDU0, QOFF = LAYER ? 0 : 5120, NQH = LAYER ? 16 : 8, KOFF_ = LAYER ? 2048 : 6144, NKH = LAYER ? 4 : 2, VOFF = LAYER ? 2560 : 6400;
    const float* qn = p.in[LAYER ? 23 : 16]; const float* kn = p.in[LAYER ? 24 : 17];
    float* outk = p.out + (LAYER ? OUT_L1K : OUT_L0K); float* outv = p.out + (LAYER ? OUT_L1V : OUT_L0V);
    const float* ck = p.in[LAYER ? 5 : 3]; const float* cv = p.in[LAYER ? 6 : 4];
    bf16_t* U = (bf16_t*)(p.ws + WS_U); bf16_t* KS = (bf16_t*)(p.ws + WS_KS); bf16_t* VS = (bf16_t*)(p.ws + WS_VS); bf16_t* KP = (bf16_t*)(p.ws + WS_KP); bf16_t* VP = (bf16_t*)(p.ws + WS_VP);
    const int lane = threadIdx.x & 63, gw = blockIdx.x * 8 + (threadIdx.x >> 6), nw = gridDim.x * 8;
    const int a = lane >> 5, i = lane & 31, e0 = 64 * a + i, e1 = e0 + 32;
    const float qn0 = qn[e0], qn1 = qn[e1], kn0 = kn[e0], kn1 = kn[e1];
    const float inv = exp2f(-(float)i * (13.287712379549449f / 32.f));
    for (int tok = gw; tok < NTOK; tok += nw) {
        const bool samp = tok >= NPTOK; int b, t; if (samp) { b = (tok - NPTOK) >> 11; t = (tok - NPTOK) & 2047; } else { b = tok >> 8; t = tok & 255; }
        float cs = 1.f, sn = 0.f;
        if (samp) { const int pos = a ? (t & 63) : (t >> 6); float rev = (float)pos * inv * 0.15915494309189535f; rev -= floorf(rev); sn = __builtin_amdgcn_sinf(rev); cs = __builtin_amdgcn_cosf(rev); }
        bf16_t* u = U + (size_t)tok * LDU;
#pragma unroll 4
        for (int h = 0; h < NQH; ++h) { bf16_t* q = u + QOFF + h * 128; const float x0 = bf2f(q[e0]), x1 = bf2f(q[e1]);
            const float rstd = rsqrtf(wave_sum(x0 * x0 + x1 * x1) * (1.f / 128.f) + 1e-6f);
            const float y0 = x0 * rstd * qn0, y1 = x1 * rstd * qn1;
            q[e0] = f2bf(y0 * cs - y1 * sn); q[e1] = f2bf(y1 * cs + y0 * sn); }
#pragma unroll
        for (int h = 0; h < NKH; ++h) { const bf16_t* kk = u + KOFF_ + h * 128; const float x0 = bf2f(kk[e0]), x1 = bf2f(kk[e1]);
            const float rstd = rsqrtf(wave_sum(x0 * x0 + x1 * x1) * (1.f / 128.f) + 1e-6f);
            const float y0 = x0 * rstd * kn0, y1 = x1 * rstd * kn1;
            const bf16_t* vv = u + VOFF + h * 128; const bf16_t v0 = vv[e0], v1 = vv[e1];
            if (!samp) { float* ok = outk + ((size_t)tok * NKH + h) * 128; ok[e0] = y0; ok[e1] = y1; float* ov = outv + ((size_t)tok * NKH + h) * 128; ov[e0] = bf2f(v0); ov[e1] = bf2f(v1);
                const size_t o = ((size_t)(b * NKH + h) * 256 + t) * 128; KP[o + e0] = f2bf(y0); KP[o + e1] = f2bf(y1); VP[o + e0] = v0; VP[o + e1] = v1; }
            else { const size_t o = ((size_t)(b * NKH + h) * 2304 + t) * 128; KS[o + e0] = f2bf(y0 * cs - y1 * sn); KS[o + e1] = f2bf(y1 * cs + y0 * sn); VS[o + e0] = v0; VS[o + e1] = v1; } }
    }
    for (int r = gw; r < 8 * 256 * NKH; r += nw) { const int b = r / (256 * NKH), j = (r / NKH) & 255, h = r % NKH;
        const size_t o = ((size_t)(b * NKH + h) * 2304 + 2048 + j) * 128 + 2 * lane;
        const float k0 = ck[(size_t)r * 128 + 2 * lane], k1 = ck[(size_t)r * 128 + 2 * lane + 1], v0 = cv[(size_t)r * 128 + 2 * lane], v1 = cv[(size_t)r * 128 + 2 * lane + 1];
        *(unsigned*)(KS + o) = cvt_pk_bf16(k0, k1); *(unsigned*)(VS + o) = cvt_pk_bf16(v0, v1); }
}

__device__ __forceinline__ void phase_comb0(const Params& p) {
    const bf16_t* U = (const bf16_t*)(p.ws + WS_U); bf16_t* MIX = (bf16_t*)(p.ws + WS_H);
    const int lane = threadIdx.x & 63, gw = blockIdx.x * 8 + (threadIdx.x >> 6), nw = gridDim.x * 8;
    const float on0 = p.in[15][2 * lane], on1 = p.in[15][2 * lane + 1];
    for (int tok = gw; tok < NTOK; tok += nw) { const bf16_t* u = U + (size_t)tok * LDU0;
#pragma unroll 4
        for (int h = 0; h < 8; ++h) { const unsigned wf = *(const unsigned*)(u + 1024 + h * 128 + 2 * lane), wb = *(const unsigned*)(u + 2048 + h * 128 + 2 * lane), wg = *(const unsigned*)(u + 4096 + h * 128 + 2 * lane);
            const float s0 = __uint_as_float(wf << 16) + __uint_as_float(wb << 16), s1 = __uint_as_float(wf & 0xffff0000u) + __uint_as_float(wb & 0xffff0000u);
            const float rstd = rsqrtf(wave_sum(s0 * s0 + s1 * s1) * (1.f / 128.f) + 1e-6f);
            const float g0 = __uint_as_float(wg << 16), g1 = __uint_as_float(wg & 0xffff0000u);
            *(unsigned*)(MIX + (size_t)tok * 2048 + h * 128 + 2 * lane) = cvt_pk_bf16(s0 * rstd * on0 * siluf(g0), s1 * rstd * on1 * siluf(g1)); }
    }
}

__device__ __forceinline__ void attn_item0(const Params& p, char* lds, int a) {
    const bf16_t* U = (const bf16_t*)(p.ws + WS_U); bf16_t* MIX = (bf16_t*)(p.ws + WS_H);
    if (a < 512) { const int b = a >> 6, h = (a >> 3) & 7, qb = a & 7, kvh = h >> 2; const size_t row = NPTOK + (size_t)b * 2048 + qb * 256;
        attn_body<LDU0>(U + row * LDU0 + 5120 + h * 128, (const bf16_t*)(p.ws + WS_KS) + (size_t)(b * 2 + kvh) * 2304 * 128, (const bf16_t*)(p.ws + WS_VS) + (size_t)(b * 2 + kvh) * 2304 * 128,
                        U + row * LDU0 + 6656 + h * 128, MIX + row * 2048 + 1024 + h * 128, 36, 4, 2048, 0, false, qb * 256, false, 0.f, lds);
    } else { const int a2 = a - 512, b = a2 >> 3, h = a2 & 7, kvh = h >> 2; const size_t row = (size_t)b * 256;
        attn_body<LDU0>(U + row * LDU0 + 5120 + h * 128, (const bf16_t*)(p.ws + WS_KP) + (size_t)(b * 2 + kvh) * 256 * 128, (const bf16_t*)(p.ws + WS_VP) + (size_t)(b * 2 + kvh) * 256 * 128,
                        U + row * LDU0 + 6656 + h * 128, MIX + row * 2048 + 1024 + h * 128, 4, 0, 0, 0, false, 0, false, 0.f, lds); }
}
__device__ __forceinline__ void attn_item1(const Params& p, char* lds, int a) {
    const bf16_t* U = (const bf16_t*)(p.ws + WS_U); bf16_t* MIX = (bf16_t*)(p.ws + WS_H);
    if (a < 1024) { const int b = a >> 7, h = (a >> 3) & 15, qb = a & 7, kvh = h >> 2; const size_t row = NPTOK + (size_t)b * 2048 + qb * 256;
        const int ls = (4 * qb - 2) < 0 ? 0 : 4 * qb - 2, le = (4 * qb + 6) > 32 ? 32 : 4 * qb + 6;
        attn_body<LDU1>(U + row * LDU1 + h * 128, (const bf16_t*)(p.ws + WS_KS) + (size_t)(b * 4 + kvh) * 2304 * 128, (const bf16_t*)(p.ws + WS_VS) + (size_t)(b * 4 + kvh) * 2304 * 128,
                        U + row * LDU1 + 3072 + h * 128, MIX + row * 2048 + h * 128, 4 + le - ls, 4, 2048, ls, true, qb * 256, true, p.in[25][h], lds);
    } else { const int a2 = a - 1024, b = a2 >> 4, h = a2 & 15, kvh = h >> 2; const size_t row = (size_t)b * 256;
        attn_body<LDU1>(U + row * LDU1 + h * 128, (const bf16_t*)(p.ws + WS_KP) + (size_t)(b * 4 + kvh) * 256 * 128, (const bf16_t*)(p.ws + WS_VP) + (size_t)(b * 4 + kvh) * 256 * 128,
                        U + row * LDU1 + 3072 + h * 128, MIX + row * 2048 + h * 128, 4, 0, 0, 0, false, 0, true, p.in[25][h], lds); }
}

template <class Epi>
__device__ __forceinline__ void phase_gemm(unsigned char* shm, const bf16_t* A, const bf16_t* Bt, int N, const Epi& E) {
    Gemm g; g.A = A; g.Bt = Bt; g.M = NTOK; g.N = N; g.K = 2048;
    StaticOrder S; S.init(NTOK, N, (int)gridDim.x, (int)blockIdx.x);
    gemm_phase<Epi, StaticOrder, false>((PG8_LAS unsigned char*)shm, g, S, E, nullptr);
}

constexpr int NPHASE = 12;
#define GSYNC(n) do { if (ph0 <= (n) && (n) + 1 < ph1) { __threadfence(); cg::this_grid().sync(); } } while (0)
__global__ void __launch_bounds__(512) mega(Params p, int ph0, int ph1) {
    extern __shared__ __attribute__((aligned(16))) unsigned char shm[];
    char* lds = (char*)shm;
#if (PHSEL >> 0) & 1
    if (ph0 <= 0 && 0 < ph1) { phase_prologue(p, lds);
        }
    GSYNC(0);
#endif
#if (PHSEL >> 1) & 1
    if (ph0 <= 1 && 1 < ph1) { phase_norm(p.in[0], p.in[1], p.in[10], (const float*)(p.ws + WS_MOD), (bf16_t*)(p.ws + WS_H));
        }
    GSYNC(1);
#endif
#if (PHSEL >> 2) & 1
    if (ph0 <= 2 && 2 < ph1) { { EpiU E; E.O = (bf16_t*)(p.ws + WS_U); E.ldc = LDU0; phase_gemm(shm, (const bf16_t*)(p.ws + WS_H), (const bf16_t*)(p.ws + WS_WT_IN0), 7680, E); }
        }
    GSYNC(2);
#endif
#if (PHSEL >> 3) & 1
    if (ph0 <= 3 && 3 < ph1) { phase_prep<0>(p);
        }
    GSYNC(3);
#endif
#if (PHSEL >> 4) & 1
    if (ph0 <= 4 && 4 < ph1) {
            for (int item = blockIdx.x; item < 384 + 640; item += gridDim.x) { __syncthreads(); if (item < 384) hgrn_chain(p, lds, item); else attn_item0(p, lds, item - 384); }

        }
    GSYNC(4);
#endif
#if (PHSEL >> 5) & 1
    if (ph0 <= 5 && 5 < ph1) { phase_comb0(p);
        }
    GSYNC(5);
#endif
#if (PHSEL >> 6) & 1
    if (ph0 <= 6 && 6 < ph1) { { EpiRes E; E.Y = p.out; E.xp = p.in[0]; E.xs = p.in[1]; E.mod = (const float*)(p.ws + WS_MOD);
                  phase_gemm(shm, (const bf16_t*)(p.ws + WS_H), (const bf16_t*)(p.ws + WS_WT_OUT0), 2048, E); }
        }
    GSYNC(6);
#endif
#if (PHSEL >> 7) & 1
    if (ph0 <= 7 && 7 < ph1) { phase_norm(p.out, p.out + (size_t)NPTOK * 2048, p.in[18], (const float*)(p.ws + WS_MOD) + 9 * 6144, (bf16_t*)(p.ws + WS_H));
        }
    GSYNC(7);
#endif
#if (PHSEL >> 8) & 1
    if (ph0 <= 8 && 8 < ph1) { { EpiU E; E.O = (bf16_t*)(p.ws + WS_U); E.ldc = LDU1; phase_gemm(shm, (const bf16_t*)(p.ws + WS_H), (const bf16_t*)(p.ws + WS_WT_IN1), 5120, E); }
        }
    GSYNC(8);
#endif
#if (PHSEL >> 9) & 1
    if (ph0 <= 9 && 9 < ph1) { phase_prep<1>(p);
        }
    GSYNC(9);
#endif
#if (PHSEL >> 10) & 1
    if (ph0 <= 10 && 10 < ph1) {
            for (int item = blockIdx.x; item < 1280; item += gridDim.x) { __syncthreads(); attn_item1(p, lds, item); }

        }
    GSYNC(10);
#endif
#if (PHSEL >> 11) & 1
    if (ph0 <= 11 && 11 < ph1) { { EpiRes E; E.Y = p.out; E.xp = p.out; E.xs = p.out + (size_t)NPTOK * 2048; E.mod = (const float*)(p.ws + WS_MOD) + 9 * 6144;
                   phase_gemm(shm, (const bf16_t*)(p.ws + WS_H), (const bf16_t*)(p.ws + WS_WT_OUT1), 2048, E); }
        }
    GSYNC(11);
#endif
}

extern "C" void kernel_launch(void* const* d_in, const int* in_sizes, int n_in, void* d_out, int out_size, void* d_ws, size_t ws_size, hipStream_t stream) {
    static int grid_blocks = 0;
    if (!grid_blocks) {
        if (ws_size < WS_END) { fprintf(stderr, "workspace too small: %zu < %zu\n", ws_size, WS_END); return; }
        if (hipFuncSetAttribute((const void*)mega, hipFuncAttributeMaxDynamicSharedMemorySize, LDS_BYTES) != hipSuccess) { fprintf(stderr, "hipFuncSetAttribute failed\n"); return; }
        int dev = 0, cus = 0, per_cu = 0;
        hipGetDevice(&dev);
        hipDeviceGetAttribute(&cus, hipDeviceAttributeMultiprocessorCount, dev);
        hipOccupancyMaxActiveBlocksPerMultiprocessor(&per_cu, mega, 512, LDS_BYTES);
        if (per_cu < 1) { fprintf(stderr, "occupancy query returned %d\n", per_cu); return; }
        grid_blocks = cus;
    }
    Params p{};
    for (int i = 0; i < 26; ++i) p.in[i] = (const float*)d_in[i];
    p.out = (float*)d_out; p.ws = (char*)d_ws;
#if MK_MULTI
    for (int ph = 0; ph < NPHASE; ++ph) hipLaunchKernelGGL(mega, dim3(grid_blocks), dim3(512), LDS_BYTES, stream, p, ph, ph + 1);
#else
    int ph0 = 0, ph1 = NPHASE;
    void* args[] = {&p, &ph0, &ph1};
    hipError_t e = hipLaunchCooperativeKernel((void*)mega, dim3(grid_blocks), dim3(512), args, LDS_BYTES, stream);
    if (e != hipSuccess) fprintf(stderr, "cooperative launch failed: %s (grid %d)\n", hipGetErrorString(e), grid_blocks);
#endif
}
```

```cpp
#include <hip/hip_runtime.h>
#include <hip/hip_cooperative_groups.h>
#include <cstdio>
#include <cstdint>
namespace cg = cooperative_groups;

#ifndef PHSEL
#define PHSEL 0xFFF
#endif
#ifndef REPMASK
#define REPMASK 0
#endif
#ifndef MK_MULTI
#define MK_MULTI 0
#endif

constexpr int NTOK = 20480, NPTOK = 4096, DM = 2048;
constexpr int LDU0 = 7680, LDU1 = 5120;
constexpr size_t WS_WT_IN0 = 0;
constexpr size_t WS_WT_OUT0 = WS_WT_IN0 + (size_t)7680 * 2048 * 2;
constexpr size_t WS_WT_IN1 = WS_WT_OUT0 + (size_t)2048 * 2048 * 2;
constexpr size_t WS_WT_OUT1 = WS_WT_IN1 + (size_t)5120 * 2048 * 2;
constexpr size_t WS_MOD = WS_WT_OUT1 + (size_t)2048 * 2048 * 2;
constexpr size_t WS_LB = WS_MOD + (size_t)2 * 9 * 6144 * 4;
constexpr size_t WS_H = WS_LB + 8192;
constexpr size_t WS_U = WS_H + (size_t)NTOK * 2048 * 2;
constexpr size_t WS_KS = WS_U + (size_t)NTOK * 7680 * 2;
constexpr size_t WS_VS = WS_KS + (size_t)8 * 4 * 2304 * 128 * 2;
constexpr size_t WS_KP = WS_VS + (size_t)8 * 4 * 2304 * 128 * 2;
constexpr size_t WS_VP = WS_KP + (size_t)16 * 4 * 256 * 128 * 2;
constexpr size_t WS_BAR = WS_VP + (size_t)16 * 4 * 256 * 128 * 2;
constexpr size_t WS_END = WS_BAR + 16384;
constexpr size_t OUT_STATE = 41943040, OUT_L0K = 46137344, OUT_L0V = 47185920, OUT_L1K = 48234496, OUT_L1V = 50331648;
constexpr int O_LDS_OFF = 67584;
constexpr int LDS_BYTES = 2 * 38400 + 2 * 8704 + 6 * 8704;

struct Params { const float* in[26]; float* out; char* ws; };

namespace pg8 {
#define PG8_LAS __attribute__((address_space(3)))
typedef unsigned short bf16_t;
typedef short bf16x8 __attribute__((ext_vector_type(8)));
typedef float f32x4 __attribute__((ext_vector_type(4)));
typedef unsigned u32x4 __attribute__((ext_vector_type(4)));
constexpr int BM = 256, BK = 64, HALF = 128, HTB = HALF * BK * 2  , STAGE_BYTES = 8 * HTB, NXCD = 8, WGM = 8;

__host__ __device__ __forceinline__ int lds_byte(int r, int c) { const int st = (r >> 4) * 2 + (c >> 5), rr = r & 15, cc = c & 31, ob = rr * 64 + cc * 2; return st * 1024 + (ob ^ (((ob >> 9) & 1) << 5)); }
__host__ __device__ __forceinline__ void stage_rc(int b, int& R, int& C) { const int st = b / 1024, sb = b % 1024, swz = sb ^ (((sb >> 9) & 1) << 5); R = (st >> 1) * 16 + swz / 64; C = (st & 1) * 32 + (swz % 64) / 2; }
__host__ __device__ __forceinline__ int perm32(int rho) { const int n = rho >> 4, i = rho & 15; return 8 * (i >> 2) + 4 * n + (i & 3); }

struct Unit { int pm, pn; };
struct Gemm { const bf16_t* A; const bf16_t* Bt; int M, N, K; };

struct StaticOrder {
    int nM, nN, nwg, G, c;
    __host__ __device__ void init(int M, int N, int G_, int c_) { nM = M / BM; nN = N / BM; nwg = nM * nN; G = G_; c = c_; }
    __host__ __device__ bool next(int i, Unit& u) const {
        const long L = (long)i * G + c; if (L >= nwg) return false;
        int wgid = (int)L; { const int q = nwg / NXCD, r = nwg % NXCD, xcd = wgid % NXCD, off = wgid / NXCD; wgid = (xcd < r ? xcd * (q + 1) : r * (q + 1) + (xcd - r) * q) + off; }
        const int nig = WGM * nN, gid = wgid / nig, fm = gid * WGM, gsz = (nM - fm) < WGM ? (nM - fm) : WGM;
        u.pm = fm + ((wgid % nig) % gsz); u.pn = (wgid % nig) / gsz; return true;
    }
    __device__ __forceinline__ void a_ready(const Unit&) const {}
    __device__ __forceinline__ void done(const Unit&) const {}
};
__device__ __forceinline__ unsigned cvt_pk_bf16(float lo, float hi) { unsigned r; asm volatile("v_cvt_pk_bf16_f32 %0, %1, %2" : "=v"(r) : "v"(lo), "v"(hi)); return r; }


template <class Epi, class Sched, bool STAMP = false>
__device__ __forceinline__ void gemm_phase(PG8_LAS unsigned char* lds, const Gemm g, const Sched& S, const Epi& E, unsigned long long* stamps) {
    const int tid = threadIdx.x, wid = __builtin_amdgcn_readfirstlane(tid >> 6), lane = tid & 63, wr = wid >> 2, wc = wid & 3, fr = lane & 15, fq = lane >> 4;
    const int K = g.K, nt = K / BK;
    int ts_lo = 0, ts_hi = 0, nts = 0; const unsigned long long rt_entry = STAMP ? (unsigned long long)wall_clock64() : 0ull;
#define PG8_STAMP() do { if (STAMP && wid == 0 && nts < 64) { const unsigned long long _c = (unsigned long long)clock64(); \
        ts_lo = (lane == nts) ? (int)(unsigned)_c : ts_lo; ts_hi = (lane == nts) ? (int)(unsigned)(_c >> 32) : ts_hi; ++nts; } } while (0)
    PG8_STAMP();
    unsigned voffA[2], voffB[2];
#pragma unroll
    for (int i = 0; i < 2; ++i) { int R, C; stage_rc(tid * 16 + i * 8192, R, C); const int Rb = Epi::PERM ? ((R & ~31) + perm32(R & 31)) : R;
        voffA[i] = (unsigned)(R * K + C) * 2u; voffB[i] = (unsigned)(Rb * K + C) * 2u; }
    const size_t kstep = (size_t)(BK * 2);
    const size_t hstep = (size_t)HALF * K * 2;
    const size_t tstep = 2 * hstep;
    const unsigned ldsw = (unsigned)wid * 1024u;
    const int aoff = lds_byte(wr * 64 + fr, fq * 8), boff = lds_byte(wc * 32 + fr, fq * 8);
#define PG8_SA(b, h) (((b) * 2 + (h)) * HTB)
#define PG8_SB(b, h) ((4 + (b) * 2 + (h)) * HTB)
#define PG8_STAGE(bufoff, gbase, voff) do { _Pragma("unroll") for (int _i = 0; _i < 2; ++_i) \
        __builtin_amdgcn_global_load_lds((const unsigned*)((const char*)(gbase) + (voff)[_i]), (PG8_LAS unsigned*)(lds + (bufoff) + ldsw + _i * 8192), 16, 0, 0); } while (0)
#define PG8_LDA(dst, b, h) do { _Pragma("unroll") for (int m = 0; m < 4; ++m) _Pragma("unroll") for (int k = 0; k < 2; ++k) dst[m][k] = *(const PG8_LAS bf16x8*)(lds + PG8_SA(b, h) + aoff + m * 2048 + k * 1024); } while (0)
#define PG8_LDB(dst, b, h) do { _Pragma("unroll") for (int n = 0; n < 2; ++n) _Pragma("unroll") for (int k = 0; k < 2; ++k) dst[n][k] = *(const PG8_LAS bf16x8*)(lds + PG8_SB(b, h) + boff + n * 2048 + k * 1024); } while (0)
#define PG8_MMA(ai, bj, At, Bt) do { __builtin_amdgcn_s_setprio(1); _Pragma("unroll") for (int m = 0; m < 4; ++m) _Pragma("unroll") for (int n = 0; n < 2; ++n) _Pragma("unroll") for (int k = 0; k < 2; ++k) \
        acc[ai][bj][m][n] = __builtin_amdgcn_mfma_f32_16x16x32_bf16(Bt[n][k], At[m][k], acc[ai][bj][m][n], 0, 0, 0); __builtin_amdgcn_s_setprio(0); } while (0)
#define PG8_WAIT_V(n) asm volatile("s_waitcnt vmcnt(" #n ")" ::: "memory")
#define PG8_WAIT_L(n) asm volatile("s_waitcnt lgkmcnt(" #n ")" ::: "memory")
#define PG8_BAR __builtin_amdgcn_s_barrier()
#define PG8_SCHED __builtin_amdgcn_sched_barrier(0)
    Unit cur, nxt; int ui = 0;
    if (!S.next(0, cur)) return;
    f32x4 acc[2][2][4][2];
#pragma unroll
    for (int a = 0; a < 2; ++a)
#pragma unroll
        for (int b = 0; b < 2; ++b)
#pragma unroll
            for (int m = 0; m < 4; ++m)
#pragma unroll
                for (int n = 0; n < 2; ++n) acc[a][b][m][n] = (f32x4){0.f, 0.f, 0.f, 0.f};
    bf16x8 At[4][2], B0[2][2], B1[2][2];
    const char* cA = (const char*)g.A + (size_t)cur.pm * tstep; const char* cB = (const char*)g.Bt + (size_t)cur.pn * tstep;
    S.a_ready(cur);
    PG8_STAGE(PG8_SB(0, 0), cB, voffB); PG8_STAGE(PG8_SA(0, 0), cA, voffA); PG8_STAGE(PG8_SB(0, 1), cB + hstep, voffB); PG8_STAGE(PG8_SA(0, 1), cA + hstep, voffA);
    if (wr == 1) PG8_BAR;
    PG8_WAIT_V(4); PG8_BAR;
    PG8_STAGE(PG8_SB(1, 0), cB + kstep, voffB); PG8_STAGE(PG8_SA(1, 0), cA + kstep, voffA); PG8_STAGE(PG8_SB(1, 1), cB + hstep + kstep, voffB);
    PG8_WAIT_V(6); PG8_BAR;
    PG8_STAMP();
    for (;;) {
        const bool has_next = S.next(ui + 1, nxt);
        const char* nA = has_next ? (const char*)g.A + (size_t)nxt.pm * tstep : cA; const char* nB = has_next ? (const char*)g.Bt + (size_t)nxt.pn * tstep : cB;
        for (int t = 0; t < nt; t += 2) {
            const bool last = (t == nt - 2);
            const char* a1 = cA + (size_t)(t + 1) * kstep;
            const char* a2 = last ? nA : cA + (size_t)(t + 2) * kstep; const char* b2 = last ? nB : cB + (size_t)(t + 2) * kstep;
            const char* a3 = a2 + kstep; const char* b3 = b2 + kstep;
            if (last && has_next) S.a_ready(nxt);
            PG8_LDB(B0, 0, 0); PG8_SCHED; PG8_LDA(At, 0, 0); PG8_STAGE(PG8_SA(1, 1), a1 + hstep, voffA);
            PG8_WAIT_L(8); PG8_BAR; PG8_WAIT_L(0); PG8_MMA(0, 0, At, B0); PG8_BAR; PG8_SCHED;
            PG8_LDB(B1, 0, 1); PG8_STAGE(PG8_SB(0, 0), b2, voffB);
            PG8_BAR; PG8_WAIT_L(0); PG8_MMA(0, 1, At, B1); PG8_BAR;
            PG8_LDA(At, 0, 1); PG8_STAGE(PG8_SA(0, 0), a2, voffA);
            PG8_BAR; PG8_WAIT_L(0); PG8_MMA(1, 0, At, B0); PG8_BAR; PG8_SCHED;
            PG8_STAGE(PG8_SB(0, 1), b2 + hstep, voffB);
            PG8_WAIT_V(6); PG8_BAR; PG8_MMA(1, 1, At, B1); PG8_BAR;
            PG8_LDB(B0, 1, 0); PG8_SCHED; PG8_LDA(At, 1, 0); PG8_STAGE(PG8_SA(0, 1), a2 + hstep, voffA);
            PG8_WAIT_L(8); PG8_BAR; PG8_WAIT_L(0); PG8_MMA(0, 0, At, B0); PG8_BAR; PG8_SCHED;
            PG8_LDB(B1, 1, 1); PG8_STAGE(PG8_SB(1, 0), b3, voffB);
            PG8_BAR; PG8_WAIT_L(0); PG8_MMA(0, 1, At, B1); PG8_BAR;
            PG8_LDA(At, 1, 1); PG8_STAGE(PG8_SA(1, 0), a3, voffA);
            PG8_BAR; PG8_WAIT_L(0); PG8_MMA(1, 0, At, B0); PG8_BAR; PG8_SCHED;
            PG8_STAGE(PG8_SB(1, 1), b3 + hstep, voffB);
            PG8_WAIT_V(6); PG8_BAR; PG8_MMA(1, 1, At, B1); PG8_BAR;
        }
        PG8_STAMP();
        if constexpr (!Epi::AFTER_DRAIN) { E(acc, cur, wr, wc, fr, fq); S.done(cur); }
        PG8_STAMP();
        if (!has_next) break;
#pragma unroll
        for (int a = 0; a < 2; ++a)
#pragma unroll
            for (int b = 0; b < 2; ++b)
#pragma unroll
                for (int m = 0; m < 4; ++m)
#pragma unroll
                    for (int n = 0; n < 2; ++n) acc[a][b][m][n] = (f32x4){0.f, 0.f, 0.f, 0.f};
        cur = nxt; cA = nA; cB = nB; ++ui;
    }
    PG8_WAIT_V(0);
    if (wr == 0) PG8_BAR;
    PG8_BAR;
    if constexpr (Epi::AFTER_DRAIN) { E.fused(acc, cur, wr, wc, fr, fq, lds, wid, lane); S.done(cur); }
    PG8_STAMP();
    if (STAMP && wid == 0) { stamps[lane] = lane < nts ? (((unsigned long long)(unsigned)ts_hi << 32) | (unsigned)ts_lo) : 0ull;
        if (lane == 62) stamps[62] = rt_entry; if (lane == 63) stamps[63] = (unsigned long long)wall_clock64(); }
#undef PG8_STAMP
#undef PG8_SA
#undef PG8_SB
#undef PG8_STAGE
#undef PG8_LDA
#undef PG8_LDB
#undef PG8_MMA
#undef PG8_WAIT_V
#undef PG8_WAIT_L
#undef PG8_BAR
#undef PG8_SCHED
}
}
using namespace pg8;
typedef float f32x16 __attribute__((ext_vector_type(16)));
typedef short s16x4 __attribute__((ext_vector_type(4)));
typedef unsigned u32x2 __attribute__((ext_vector_type(2)));

__device__ __forceinline__ float bf2f(bf16_t x) { return __uint_as_float(((unsigned)x) << 16); }
__device__ __forceinline__ bf16_t f2bf(float f) { unsigned u = __float_as_uint(f); u += 0x7FFFu + ((u >> 16) & 1u); return (bf16_t)(u >> 16); }
__device__ __forceinline__ float wave_sum(float v) {
#pragma unroll
    for (int o = 32; o > 0; o >>= 1) v += __shfl_xor(v, o);
    return v;
}
__device__ __forceinline__ float fexp(float x) { return __builtin_amdgcn_exp2f(x * 1.4426950408889634f); }
__device__ __forceinline__ float flog(float x) { return __builtin_amdgcn_logf(x) * 0.6931471805599453f; }
__device__ __forceinline__ float siluf(float a) { return a * __builtin_amdgcn_rcpf(1.f + __expf(-a)); }

struct EpiU {
    static constexpr bool PERM = true, AFTER_DRAIN = false;
    bf16_t* O; int ldc;
    __device__ __forceinline__ void operator()(const f32x4 (&acc)[2][2][4][2], const Unit& u, int wr, int wc, int fr, int fq) const {
        const int row0 = u.pm * BM + wr * 64 + fr, col0 = u.pn * BM + wc * 32 + 8 * fq;
#pragma unroll
        for (int ai = 0; ai < 2; ++ai)
#pragma unroll
            for (int m = 0; m < 4; ++m) { bf16_t* rowp = O + (size_t)(row0 + ai * HALF + m * 16) * ldc + col0;
#pragma unroll
                for (int bj = 0; bj < 2; ++bj) { const f32x4 v0 = acc[ai][bj][m][0], v1 = acc[ai][bj][m][1];
                    u32x4 w = {cvt_pk_bf16(v0[0], v0[1]), cvt_pk_bf16(v0[2], v0[3]), cvt_pk_bf16(v1[0], v1[1]), cvt_pk_bf16(v1[2], v1[3])};
                    *(u32x4*)(rowp + bj * HALF) = w; } }
    }
};
struct EpiRes {
    static constexpr bool PERM = false, AFTER_DRAIN = false;
    float* Y; const float* xp; const float* xs; const float* mod;
    __device__ __forceinline__ void operator()(const f32x4 (&acc)[2][2][4][2], const Unit& u, int wr, int wc, int fr, int fq) const {
        const int row0 = u.pm * BM + wr * 64 + fr, col0 = u.pn * BM + wc * 32 + 4 * fq;
        const bool prompt = u.pm < 16; const int j = prompt ? 0 : 1 + ((u.pm - 16) >> 3);
        const float* gp = mod + j * 6144 + 4096 + col0;
        f32x4 gv[2][2];
#pragma unroll
        for (int bj = 0; bj < 2; ++bj)
#pragma unroll
            for (int n = 0; n < 2; ++n) gv[bj][n] = *(const f32x4*)(gp + bj * HALF + n * 16);
#pragma unroll
        for (int ai = 0; ai < 2; ++ai) {
            f32x4 xb[4][2][2];
#pragma unroll
            for (int m = 0; m < 4; ++m) { const int r = row0 + ai * HALF + m * 16;
                const float* bp = (prompt ? xp + (size_t)r * 2048 : xs + (size_t)(r - NPTOK) * 2048) + col0;
#pragma unroll
                for (int bj = 0; bj < 2; ++bj)
#pragma unroll
                    for (int n = 0; n < 2; ++n) xb[m][bj][n] = *(const f32x4*)(bp + bj * HALF + n * 16); }
#pragma unroll
            for (int m = 0; m < 4; ++m) { const int r = row0 + ai * HALF + m * 16; float* yp = Y + (size_t)r * 2048 + col0;
#pragma unroll
                for (int bj = 0; bj < 2; ++bj)
#pragma unroll
                    for (int n = 0; n < 2; ++n) *(f32x4*)(yp + bj * HALF + n * 16) = xb[m][bj][n] + gv[bj][n] * acc[ai][bj][m][n]; }
        }
    }
};

constexpr int QBLK = 32, KVBLK = 64;
constexpr float SCALE = 0.088388347648318440f;
constexpr float THR = 8.f;
constexpr size_t SHM_V = KVBLK * 128 * 2, SHM_K = KVBLK * 128 * 2;
constexpr int Q_LDS_OFF = 2 * 16384 + 2 * 16384 + 8 * 64 * 4;
#define KSWZ(row, colB) ((row) * 256 + ((colB) ^ (((row) & 7) << 4)))
#define SBAR() __builtin_amdgcn_sched_barrier(0)
__device__ __forceinline__ int crow(int r, int hi) { return (r & 3) + 8 * (r >> 2) + 4 * hi; }

__device__ __forceinline__ void partialSM(f32x16& p0, f32x16& p1, float& m_reg, float& mn, float& alpha, bool domask, int kd, int hi) {
  constexpr float C = SCALE * 1.4426950408889634f;
  if (domask) {
#pragma unroll
    for (int r = 0; r < 16; ++r) { const int kk = kd + crow(r, hi); p0[r] = (kk >= -128 && kk <= 128) ? p0[r] : -1e30f; p1[r] = (kk + 32 >= -128 && kk + 32 <= 128) ? p1[r] : -1e30f; }
  }
  float pmax = p0[0];
#pragma unroll
  for (int r = 1; r < 16; ++r) pmax = fmaxf(pmax, p0[r]);
#pragma unroll
  for (int r = 0; r < 16; ++r) pmax = fmaxf(pmax, p1[r]);
  { auto rr = __builtin_amdgcn_permlane32_swap(__float_as_uint(pmax), __float_as_uint(pmax), false, false);
    pmax = fmaxf(__uint_as_float(rr[0]), __uint_as_float(rr[1])); }
  if (__builtin_expect(__all(pmax - m_reg <= THR / SCALE), 1)) { mn = m_reg; alpha = 1.f; }
  else { mn = fmaxf(m_reg, pmax); alpha = __builtin_amdgcn_exp2f((m_reg - mn) * C); m_reg = mn; }
  float mnC = -mn * C;
#pragma unroll
  for (int r = 0; r < 16; ++r) p0[r] = fmaf(p0[r], C, mnC);
#pragma unroll
  for (int r = 0; r < 16; ++r) p1[r] = fmaf(p1[r], C, mnC);
#pragma unroll
  for (int r = 0; r < 16; ++r) p0[r] = __builtin_amdgcn_exp2f(p0[r]);
}
__device__ __forceinline__ void finishSM(f32x16& p0, f32x16& p1, float alpha, float& l_reg, bf16x8& pa0, bf16x8& pa1, bf16x8& pa2, bf16x8& pa3) {
#pragma unroll
  for (int r = 0; r < 16; ++r) p1[r] = __builtin_amdgcn_exp2f(p1[r]);
  float ps = 0;
#pragma unroll
  for (int r = 0; r < 16; ++r) ps += p0[r];
#pragma unroll
  for (int r = 0; r < 16; ++r) ps += p1[r];
  { auto rr = __builtin_amdgcn_permlane32_swap(__float_as_uint(ps), __float_as_uint(ps), false, false);
    ps = __uint_as_float(rr[0]) + __uint_as_float(rr[1]); }
  l_reg = l_reg * alpha + ps;
#define PK4(P, BASE, OUT) do { unsigned a0 = cvt_pk_bf16(P[BASE + 0], P[BASE + 1]), a1 = cvt_pk_bf16(P[BASE + 2], P[BASE + 3]);   \
    unsigned b0 = cvt_pk_bf16(P[BASE + 4], P[BASE + 5]), b1 = cvt_pk_bf16(P[BASE + 6], P[BASE + 7]);                              \
    auto r0 = __builtin_amdgcn_permlane32_swap(a0, b0, false, false); auto r1 = __builtin_amdgcn_permlane32_swap(a1, b1, false, false); \
    u32x4 w = {r0[0], r1[0], r0[1], r1[1]}; OUT = *reinterpret_cast<bf16x8*>(&w); } while (0)
  PK4(p0, 0, pa0); PK4(p0, 8, pa1); PK4(p1, 0, pa2); PK4(p1, 8, pa3);
#undef PK4
}
__device__ __forceinline__ void qkt(f32x16& p0, f32x16& p1, const bf16_t* Ks, const bf16x8* qr, int r32, int hi) {
  p0 = f32x16{}; p1 = f32x16{};
#pragma unroll
  for (int d0 = 0; d0 < 8; ++d0) { int cb = (d0 * 16 + hi * 8) * 2; const bf16x8 qf = qr[d0];
    bf16x8 b0 = *reinterpret_cast<const bf16x8*>((const char*)Ks + KSWZ(r32, cb));
    bf16x8 b1 = *reinterpret_cast<const bf16x8*>((const char*)Ks + KSWZ(32 + r32, cb));
    p0 = __builtin_amdgcn_mfma_f32_32x32x16_bf16(b0, qf, p0, 0, 0, 0);
    p1 = __builtin_amdgcn_mfma_f32_32x32x16_bf16(b1, qf, p1, 0, 0, 0); }
}
__device__ __forceinline__ int v_st(int k, int c) { const int kk = (k & ~0xC) | ((k & 4) << 1) | ((k & 8) >> 1); return ((kk >> 3) * 4 + (c >> 5)) * 512 + ((kk & 7) * 32 + (c & 31)) * 2; }
__device__ __forceinline__ int v_rd_base(int lane) { return ((lane & 3) << 3) | (((lane >> 2) & 3) << 6) | (((lane >> 4) & 1) << 5) | (((lane >> 5) & 1) << 8); }
constexpr int v_rd_off(int d0, int ks, int half) { return d0 * 512 + ks * 4096 + half * 2048; }
template <int OFF> __device__ __forceinline__ s16x4 tr_read(int vb) {
  s16x4 r; asm volatile("ds_read_b64_tr_b16 %0, %1 offset:%2" : "=&v"(r) : "v"(vb), "i"(OFF) : "memory"); return r;
}
template <int D0> __device__ __forceinline__ void pv_one(f32x16& od, int vb, bf16x8 pa0, bf16x8 pa1, bf16x8 pa2, bf16x8 pa3) {
  const s16x4 l0 = tr_read<v_rd_off(D0, 0, 0)>(vb), h0 = tr_read<v_rd_off(D0, 0, 1)>(vb), l1 = tr_read<v_rd_off(D0, 1, 0)>(vb), h1 = tr_read<v_rd_off(D0, 1, 1)>(vb);
  const s16x4 l2 = tr_read<v_rd_off(D0, 2, 0)>(vb), h2 = tr_read<v_rd_off(D0, 2, 1)>(vb), l3 = tr_read<v_rd_off(D0, 3, 0)>(vb), h3 = tr_read<v_rd_off(D0, 3, 1)>(vb);
  asm volatile("s_waitcnt lgkmcnt(0)" ::: "memory"); SBAR();
#define PK(L, H) (bf16x8){L[0], L[1], L[2], L[3], H[0], H[1], H[2], H[3]}
  od = __builtin_amdgcn_mfma_f32_32x32x16_bf16(pa0, PK(l0, h0), od, 0, 0, 0);
  od = __builtin_amdgcn_mfma_f32_32x32x16_bf16(pa1, PK(l1, h1), od, 0, 0, 0);
  od = __builtin_amdgcn_mfma_f32_32x32x16_bf16(pa2, PK(l2, h2), od, 0, 0, 0);
  od = __builtin_amdgcn_mfma_f32_32x32x16_bf16(pa3, PK(l3, h3), od, 0, 0, 0);
#undef PK
}
__device__ __forceinline__ void pv_d0(f32x16* o, int vb, bf16x8 pa0, bf16x8 pa1, bf16x8 pa2, bf16x8 pa3) {
  pv_one<0>(o[0], vb, pa0, pa1, pa2, pa3); pv_one<1>(o[1], vb, pa0, pa1, pa2, pa3); pv_one<2>(o[2], vb, pa0, pa1, pa2, pa3); pv_one<3>(o[3], vb, pa0, pa1, pa2, pa3);
}

template <int LDQ>
__device__ __forceinline__ void attn_body(const bf16_t* __restrict__ Qb, const bf16_t* __restrict__ Kh, const bf16_t* __restrict__ Vh,
                                          const bf16_t* __restrict__ Gb, bf16_t* __restrict__ Ob, const int NT, const int nctx, const int ctx_base,
                                          const int lat_start, const bool window, const int i0, const float* __restrict__ sinkp, char* lds, const bool pack4 = false) {
  constexpr int LDK = 128;
  int tid_ = threadIdx.x; asm volatile("" : "+v"(tid_));
  const int tid = tid_, wid = __builtin_amdgcn_readfirstlane(tid >> 6), lane = tid & 63, r32 = lane & 31, hi = lane >> 5;
  bf16_t* V_lds = (bf16_t*)lds; bf16_t* K_lds = (bf16_t*)(lds + 2 * SHM_V);
  float* ws = (float*)(lds + 2 * SHM_V + 2 * SHM_K) + wid * 64; float* li_l = ws; float* al_l = ws + 32;
  float m_reg = -1e30f, l_reg = 0; f32x16 o[4] = {};
  const int wrow = pack4 ? (wid & 1) * 32 : wid * 32, whead = pack4 ? (wid >> 1) * 128 : 0;
  bf16x8 qr[8];
  { const bf16_t* Qw = Qb + (long)(wrow + r32) * LDQ + whead + hi * 8;
#pragma unroll
    for (int d0 = 0; d0 < 8; ++d0) qr[d0] = *reinterpret_cast<const bf16x8*>(Qw + d0 * 16); }
  const int sr = tid >> 4, sc = (tid & 15) * 8, vst0 = v_st(sr, sc), vst1 = v_st(32 + sr, sc);
  const int vb0 = (int)(uintptr_t)V_lds + v_rd_base(lane);
  const int qpos = i0 + wrow + r32, qw = i0 + wrow;
  struct { bf16x8 vs0, vs1, ks0, ks1; } sr_[2];
#define KOFF(j) ((j) < nctx ? ctx_base + (j) * 64 : (lat_start + (j) - nctx) * 64)
#define DOMASK(j, k0) (window && (j) >= nctx && !(((k0) + 63 - qw <= 128) && (qw + 31 - (k0) <= 128)))
#define SLOAD(i, k0) do { sr_[i].vs0 = *(const bf16x8*)(&Vh[(long)((k0) + sr) * LDK + sc]); sr_[i].vs1 = *(const bf16x8*)(&Vh[(long)((k0) + 32 + sr) * LDK + sc]); \
    sr_[i].ks0 = *(const bf16x8*)(&Kh[(long)((k0) + sr) * LDK + sc]); sr_[i].ks1 = *(const bf16x8*)(&Kh[(long)((k0) + 32 + sr) * LDK + sc]); } while (0)
#define SWRITE(b, i) do { *(bf16x8*)((char*)V_lds + (b) * SHM_V + vst0) = sr_[i].vs0;          \
    *(bf16x8*)((char*)V_lds + (b) * SHM_V + vst1) = sr_[i].vs1; int kc = sc * 2;               \
    *(bf16x8*)((char*)K_lds + (b) * SHM_K + KSWZ(sr, kc)) = sr_[i].ks0;                       \
    *(bf16x8*)((char*)K_lds + (b) * SHM_K + KSWZ(32 + sr, kc)) = sr_[i].ks1; } while (0)
#define SWAIT() asm volatile("s_waitcnt vmcnt(4)" ::: "memory")
#define RESC(a) do { if (__any((a) < 1.f)) { if (hi == 0) al_l[r32] = (a); asm volatile("s_waitcnt lgkmcnt(0)" ::: "memory"); \
    _Pragma("unroll") for (int d = 0; d < 4; ++d) _Pragma("unroll") for (int r = 0; r < 16; ++r) o[d][r] *= al_l[crow(r, hi)]; } } while (0)
  f32x16 pA0, pA1, pB0, pB1; float mnA, mnB, alA, alB; bf16x8 pa0, pa1, pa2, pa3;
  constexpr int SE = 0, SO = 1;
  int kcur = KOFF(0);
  SLOAD(SE, kcur); asm volatile("s_waitcnt vmcnt(0)" ::: "memory"); SWRITE(0, SE); __syncthreads();
  qkt(pA0, pA1, K_lds, qr, r32, hi); partialSM(pA0, pA1, m_reg, mnA, alA, DOMASK(0, kcur), kcur - qpos, hi);
  { const int k1 = KOFF(1); SLOAD(SO, k1); } if (2 < NT) { const int k2 = KOFF(2); SLOAD(SE, k2); }
  SWAIT(); SWRITE(1, SO); __syncthreads();
  for (int j = 1; j + 1 < NT; j += 2) {
    SBAR(); qkt(pB0, pB1, (bf16_t*)((char*)K_lds + SHM_K), qr, r32, hi);
    finishSM(pA0, pA1, alA, l_reg, pa0, pa1, pa2, pa3); SBAR();
    if (j + 2 < NT) { const int kn = KOFF(j + 2); SLOAD(SO, kn); } SBAR();
    { const int kj = KOFF(j); pv_d0(o, vb0, pa0, pa1, pa2, pa3); partialSM(pB0, pB1, m_reg, mnB, alB, DOMASK(j, kj), kj - qpos, hi); }
    __syncthreads(); SWAIT(); SWRITE(0, SE);
    RESC(alB); __syncthreads();
    SBAR(); qkt(pA0, pA1, K_lds, qr, r32, hi);
    finishSM(pB0, pB1, alB, l_reg, pa0, pa1, pa2, pa3); SBAR();
    if (j + 3 < NT) { const int kn = KOFF(j + 3); SLOAD(SE, kn); } SBAR();
    { const int kj = KOFF(j + 1); pv_d0(o, vb0 + (int)SHM_V, pa0, pa1, pa2, pa3); partialSM(pA0, pA1, m_reg, mnA, alA, DOMASK(j + 1, kj), kj - qpos, hi); }
    __syncthreads(); SWAIT(); SWRITE(1, SO);
    RESC(alA); __syncthreads();
  }
  if (NT & 1) {
    finishSM(pA0, pA1, alA, l_reg, pa0, pa1, pa2, pa3); SBAR();
    pv_d0(o, vb0, pa0, pa1, pa2, pa3);
  } else {
    SBAR(); qkt(pB0, pB1, (bf16_t*)((char*)K_lds + SHM_K), qr, r32, hi);
    finishSM(pA0, pA1, alA, l_reg, pa0, pa1, pa2, pa3); SBAR();
    { const int kj = KOFF(NT - 1); pv_d0(o, vb0, pa0, pa1, pa2, pa3); partialSM(pB0, pB1, m_reg, mnB, alB, DOMASK(NT - 1, kj), kj - qpos, hi); }
    __syncthreads(); RESC(alB);
    finishSM(pB0, pB1, alB, l_reg, pa0, pa1, pa2, pa3); SBAR();
    pv_d0(o, vb0 + (int)SHM_V, pa0, pa1, pa2, pa3);
  }
  if (sinkp) l_reg += __builtin_amdgcn_exp2f(sinkp[pack4 ? (wid >> 1) : 0] * 1.4426950408889634f - m_reg * (SCALE * 1.4426950408889634f));
  if (hi == 0) li_l[r32] = l_reg; asm volatile("s_waitcnt lgkmcnt(0)" ::: "memory");
  const bf16_t* Gw = Gb + (long)wrow * LDQ + whead; bf16_t* Ow = Ob + (long)wrow * 2048 + whead;
  char* ot = lds + O_LDS_OFF + wid * 8704;
  bf16x8 gvr[8];
#pragma unroll
  for (int it = 0; it < 8; ++it) gvr[it] = *(const bf16x8*)(Gw + (long)(it * 4 + (lane >> 4)) * LDQ + (lane & 15) * 8);
  float rlv[16];
#pragma unroll
  for (int r = 0; r < 16; ++r) rlv[r] = li_l[crow(r, hi)];
  asm volatile("s_waitcnt lgkmcnt(0)" ::: "memory"); __builtin_amdgcn_sched_barrier(0);
#pragma unroll
  for (int r = 0; r < 16; ++r) { const int orow = crow(r, hi); const float rl = __builtin_amdgcn_rcpf(rlv[r]);
    const unsigned p01 = cvt_pk_bf16(o[0][r] * rl, o[1][r] * rl), p23 = cvt_pk_bf16(o[2][r] * rl, o[3][r] * rl);
    char* op = ot + orow * 272 + r32 * 2;
    *(bf16_t*)(op) = (bf16_t)(p01 & 0xffffu); *(bf16_t*)(op + 64) = (bf16_t)(p01 >> 16);
    *(bf16_t*)(op + 128) = (bf16_t)(p23 & 0xffffu); *(bf16_t*)(op + 192) = (bf16_t)(p23 >> 16); }
  asm volatile("s_waitcnt lgkmcnt(0)" ::: "memory");
  bf16x8 ovr[8];
#pragma unroll
  for (int it = 0; it < 8; ++it) ovr[it] = *(const bf16x8*)(ot + (it * 4 + (lane >> 4)) * 272 + (lane & 15) * 16);
  asm volatile("s_waitcnt lgkmcnt(0)" ::: "memory"); __builtin_amdgcn_sched_barrier(0);
#pragma unroll
  for (int it = 0; it < 8; ++it) { const int row = it * 4 + (lane >> 4), c8 = (lane & 15) * 8;
    const bf16x8 ov = ovr[it]; const bf16x8 gv = gvr[it];
    float f[8];
#pragma unroll
    for (int j = 0; j < 8; ++j) f[j] = bf2f((bf16_t)ov[j]) * siluf(bf2f((bf16_t)gv[j]));
    const u32x4 w = {cvt_pk_bf16(f[0], f[1]), cvt_pk_bf16(f[2], f[3]), cvt_pk_bf16(f[4], f[5]), cvt_pk_bf16(f[6], f[7])};
    *(u32x4*)(Ow + (long)row * 2048 + c8) = w; }
#undef SLOAD
#undef SWRITE
#undef SWAIT
#undef RESC
#undef KOFF
#undef DOMASK
}

#define MFMA16(a, b, c) __builtin_amdgcn_mfma_f32_16x16x32_bf16((a), (b), (c), 0, 0, 0)
__device__ __forceinline__ bf16x8 as_bf8(u32x4 w) { return *reinterpret_cast<bf16x8*>(&w); }
__device__ __forceinline__ void hgrn_chain(const Params& p, char* lds, int item) {
    int tid_ = threadIdx.x; asm volatile("" : "+v"(tid_));
    const int tid = tid_, wid = __builtin_amdgcn_readfirstlane(tid >> 6), lane = tid & 63, l16 = lane & 15, g = lane >> 4;
    const bool samp = item < 128; const int it = samp ? item : item - 128;
    const int b = it >> 4, h = (it >> 1) & 7, dir = it & 1;
    const int L = samp ? 2048 : 256; const long tok0 = samp ? NPTOK + (long)b * 2048 : (long)b * 256;
    const int nchunk = L >> 5;
    char* ws = p.ws; asm volatile("" : "+s"(ws));
    bf16_t* U = (bf16_t*)(ws + WS_U);
    const int d = l16 + 16 * wid, part = g;
    const int lt = tid >> 4, ld8 = (tid & 15) * 8;
    const float lbv = ((const float*)(ws + WS_LB))[dir * 1024 + h * 128 + d];
    constexpr int TILE_B = 38400;
    bf16_t* otile0 = (bf16_t*)(lds + 2 * TILE_B);
    bf16_t* raw = otile0 + 2 * 32 * 136;
    f32x4 S[8];
    if (samp) { const float* st = p.in[2] + (size_t)((b * 2 + dir) * 8 + h) * 16384;
#pragma unroll
        for (int m = 0; m < 8; ++m)
#pragma unroll
            for (int i = 0; i < 4; ++i) S[m][i] = st[(16 * m + 4 * g + i) * 128 + 16 * wid + l16];
    } else {
#pragma unroll
        for (int m = 0; m < 8; ++m) S[m] = (f32x4){0.f, 0.f, 0.f, 0.f};
    }
    const int gcol = 1024 * (1 + dir);
    bf16_t* ubase = U + h * 128 + ld8;
    bf16x8 rq, rf, ri;
#define HTOK(c) ((size_t)(tok0 + (dir ? (L - 1 - ((c) * 32 + lt)) : ((c) * 32 + lt))) * LDU0)
#define HLD(c) do { const bf16_t* u_ = ubase + HTOK(c); rq = *(const bf16x8*)(u_); rf = *(const bf16x8*)(u_ + gcol); ri = *(const bf16x8*)(u_ + 3072); } while (0)
#define HWR(c) do { bf16_t* r_ = raw + ((c) & 1) * (3 * 32 * 136) + lt * 136 + ld8; *(bf16x8*)(r_) = rq; *(bf16x8*)(r_ + 32 * 136) = rf; *(bf16x8*)(r_ + 2 * 32 * 136) = ri; } while (0)
#define HOST(c) do { *(bf16x8*)(U + HTOK(c) + gcol + h * 128 + ld8) = *(const bf16x8*)(otile0 + ((c) & 1) * (32 * 136) + lt * 136 + ld8); } while (0)
    HLD(0); HWR(0);
    if (nchunk > 1) HLD(1);
    __syncthreads();
    for (int c = 0; c < nchunk; ++c) {
        char* tb = lds + (c & 1) * TILE_B;
        bf16_t* qd = (bf16_t*)tb; bf16_t* ki = qd + 32 * 136; bf16_t* keT = ki + 32 * 136; bf16_t* vT = keT + 128 * 40; float* dec = (float*)(vT + 128 * 40);
        const bf16_t* rw = raw + (c & 1) * (3 * 32 * 136) + (part * 8) * 136 + d;
        float q[8], k[8], bl[8]; unsigned vv[4]; bf16_t rq_[8], rf_[8], ri_[8];
        float cum = 0.f;
#pragma unroll
        for (int tt = 0; tt < 8; ++tt) { rq_[tt] = rw[tt * 136]; rf_[tt] = rw[32 * 136 + tt * 136]; ri_[tt] = rw[2 * 32 * 136 + tt * 136]; }
        asm volatile("s_waitcnt lgkmcnt(0)" ::: "memory"); __builtin_amdgcn_sched_barrier(0);
#pragma unroll
        for (int tt = 0; tt < 8; ++tt) { q[tt] = siluf(bf2f(rq_[tt])); const float sg = __builtin_amdgcn_rcpf(1.f + fexp(-bf2f(rf_[tt])));
            const float f = lbv + (1.f - lbv) * sg; k[tt] = 1.f - f; cum += flog(f); bl[tt] = cum; }
#pragma unroll
        for (int tt = 0; tt < 4; ++tt) vv[tt] = (unsigned)ri_[2 * tt] | ((unsigned)ri_[2 * tt + 1] << 16);
        const float c1 = __shfl_xor(cum, 16), c2 = __shfl_xor(cum, 32), c3 = __shfl_xor(cum, 48);
        const float blast = cum + c1 + c2 + c3;
        const float off = ((part & 1) ? c1 : 0.f) + ((part & 2) ? c2 + c3 : 0.f);
        float ke[8]; const float eblast = fexp(blast);
#pragma unroll
        for (int tt = 0; tt < 8; ++tt) { const float bb = off + bl[tt]; const int t = part * 8 + tt;
            const float kiv = k[tt] * fexp(-bb); qd[t * 136 + d] = f2bf(q[tt] * fexp(bb)); ki[t * 136 + d] = f2bf(kiv); ke[tt] = kiv * eblast; }
        { u32x4 w = {cvt_pk_bf16(ke[0], ke[1]), cvt_pk_bf16(ke[2], ke[3]), cvt_pk_bf16(ke[4], ke[5]), cvt_pk_bf16(ke[6], ke[7])};
          *(u32x4*)(keT + d * 40 + part * 8) = w; u32x4 w2 = {vv[0], vv[1], vv[2], vv[3]}; *(u32x4*)(vT + d * 40 + part * 8) = w2; }
        if (part == 0) dec[d] = eblast;
        if (c >= 2) HOST(c - 2);
        if (c + 1 < nchunk) { HWR(c + 1); if (c + 2 < nchunk) HLD(c + 2); }
        __syncthreads();
        f32x4 T00 = {0.f, 0.f, 0.f, 0.f}, T01 = T00, T11 = T00;
#pragma unroll
        for (int ks = 0; ks < 4; ++ks) {
            const bf16x8 a0 = *(const bf16x8*)(ki + l16 * 136 + 32 * ks + 8 * g), a1 = *(const bf16x8*)(ki + (16 + l16) * 136 + 32 * ks + 8 * g);
            const bf16x8 b0 = *(const bf16x8*)(qd + l16 * 136 + 32 * ks + 8 * g), b1 = *(const bf16x8*)(qd + (16 + l16) * 136 + 32 * ks + 8 * g);
            T00 = MFMA16(a0, b0, T00); T01 = MFMA16(a0, b1, T01); T11 = MFMA16(a1, b1, T11);
        }
#pragma unroll
        for (int i = 0; i < 4; ++i) if (4 * g + i > l16) { T00[i] = 0.f; T11[i] = 0.f; }
        const u32x4 P0w = {cvt_pk_bf16(T00[0], T00[1]), cvt_pk_bf16(T00[2], T00[3]), 0u, 0u};
        const u32x4 P1w = {cvt_pk_bf16(T01[0], T01[1]), cvt_pk_bf16(T01[2], T01[3]), cvt_pk_bf16(T11[0], T11[1]), cvt_pk_bf16(T11[2], T11[3])};
        const bf16_t* vrow = vT + (16 * wid + l16) * 40;
        const u32x2 vlo = *(const u32x2*)(vrow + 4 * g), vhi = *(const u32x2*)(vrow + 16 + 4 * g);
        const u32x4 Bvw = {vlo[0], vlo[1], vhi[0], vhi[1]};
        f32x4 o0 = {0.f, 0.f, 0.f, 0.f}, o1 = o0;
        o0 = MFMA16(as_bf8(P0w), as_bf8(Bvw), o0); o1 = MFMA16(as_bf8(P1w), as_bf8(Bvw), o1);
#pragma unroll
        for (int ks = 0; ks < 4; ++ks) {
            const u32x2 x0 = *(const u32x2*)(qd + l16 * 136 + 32 * ks + 4 * g), x1 = *(const u32x2*)(qd + l16 * 136 + 32 * ks + 16 + 4 * g);
            const u32x2 y0 = *(const u32x2*)(qd + (16 + l16) * 136 + 32 * ks + 4 * g), y1 = *(const u32x2*)(qd + (16 + l16) * 136 + 32 * ks + 16 + 4 * g);
            const u32x4 A0w = {x0[0], x0[1], x1[0], x1[1]}, A1w = {y0[0], y0[1], y1[0], y1[1]};
            const u32x4 Bsw = {cvt_pk_bf16(S[2 * ks][0], S[2 * ks][1]), cvt_pk_bf16(S[2 * ks][2], S[2 * ks][3]),
                               cvt_pk_bf16(S[2 * ks + 1][0], S[2 * ks + 1][1]), cvt_pk_bf16(S[2 * ks + 1][2], S[2 * ks + 1][3])};
            o0 = MFMA16(as_bf8(A0w), as_bf8(Bsw), o0); o1 = MFMA16(as_bf8(A1w), as_bf8(Bsw), o1);
        }
        const bf16x8 bvv = *(const bf16x8*)(vrow + 8 * g);
#pragma unroll
        for (int m = 0; m < 8; ++m) { const f32x4 dc = *(const f32x4*)(dec + 16 * m + 4 * g); S[m] = S[m] * dc;
            const bf16x8 a = *(const bf16x8*)(keT + (16 * m + l16) * 40 + 8 * g); S[m] = MFMA16(a, bvv, S[m]); }
        bf16_t* otile = otile0 + (c & 1) * (32 * 136);
#pragma unroll
        for (int i = 0; i < 4; ++i) { otile[(4 * g + i) * 136 + 16 * wid + l16] = f2bf(o0[i]); otile[(16 + 4 * g + i) * 136 + 16 * wid + l16] = f2bf(o1[i]); }
    }
    __syncthreads();
    if (nchunk >= 2) HOST(nchunk - 2);
    HOST(nchunk - 1);
    if (!samp) { float* st = p.out + OUT_STATE + (size_t)((b * 2 + dir) * 8 + h) * 16384;
#pragma unroll
        for (int m = 0; m < 8; ++m)
#pragma unroll
            for (int i = 0; i < 4; ++i) st[(16 * m + 4 * g + i) * 128 + 16 * wid + l16] = S[m][i];
    }
#undef HLD
#undef HWR
#undef HTOK
#undef HOST
}

__device__ __forceinline__ void mod_gemv(const Params& p, char* lds, const int layer, const int first, const int stride) {
    const int tid = threadIdx.x;
    float* sl = (float*)lds;
    float* red = (float*)(lds + 73728);
    __syncthreads();
    for (int idx = tid; idx < 9 * 2048; idx += 512) { const int j = idx >> 11, k = idx & 2047; const float c = j ? p.in[7][(j - 1) * 2048 + k] : p.in[8][k]; sl[idx] = siluf(c); }
    __syncthreads();
    for (int colg = first; colg < 96; colg += stride) {
        const int lane = tid & 63, cq = lane & 15, kp = (tid >> 6) * 4 + (lane >> 4);
        const float* W = p.in[layer ? 19 : 11] + (size_t)(kp * 64) * 6144 + colg * 64 + cq * 4; const float* bm = p.in[layer ? 20 : 12];
        f32x4 acc[9];
#pragma unroll
        for (int j = 0; j < 9; ++j) acc[j] = (f32x4){0.f, 0.f, 0.f, 0.f};
        for (int k0 = 0; k0 < 64; k0 += 8) {
            f32x4 w[8];
#pragma unroll
            for (int u = 0; u < 8; ++u) w[u] = *(const f32x4*)(W + (size_t)(k0 + u) * 6144);
#pragma unroll
            for (int j = 0; j < 9; ++j) { const f32x4 s0 = *(const f32x4*)(sl + j * 2048 + kp * 64 + k0), s1 = *(const f32x4*)(sl + j * 2048 + kp * 64 + k0 + 4);
                acc[j] += w[0] * s0[0] + w[1] * s0[1] + w[2] * s0[2] + w[3] * s0[3] + w[4] * s1[0] + w[5] * s1[1] + w[6] * s1[2] + w[7] * s1[3]; }
        }
#pragma unroll
        for (int j = 0; j < 9; ++j)
#pragma unroll
            for (int e = 0; e < 4; ++e) { float v = acc[j][e]; v += __shfl_xor(v, 16); v += __shfl_xor(v, 32); acc[j][e] = v; }
        if (lane < 16) {
#pragma unroll
            for (int j = 0; j < 9; ++j) *(f32x4*)(red + ((tid >> 6) * 9 + j) * 64 + cq * 4) = acc[j]; }
        __syncthreads();
        for (int idx = tid; idx < 576; idx += 512) { const int j = idx >> 6, c2 = idx & 63; float s_ = 0.f;
#pragma unroll
            for (int q = 0; q < 8; ++q) s_ += red[(q * 9 + j) * 64 + c2];
            ((float*)(p.ws + WS_MOD))[(layer * 9 + j) * 6144 + colg * 64 + c2] = s_ + bm[colg * 64 + c2]; }
        __syncthreads();
    }
}
__device__ __forceinline__ void wt_tasks(const Params& p, char* lds, const int t0, const int cnt) {
    const int tid = threadIdx.x;
    bf16_t* T = (bf16_t*)lds;
    __syncthreads();
    for (int t = t0; t < t0 + cnt; ++t) {
        const int ct = t >> 4, kt = t & 15; const float* W; bf16_t* WT; int N, nt;
        if (ct < 120) { W = p.in[13]; WT = (bf16_t*)(p.ws + WS_WT_IN0); N = 7680; nt = ct; }
        else if (ct < 152) { W = p.in[14]; WT = (bf16_t*)(p.ws + WS_WT_OUT0); N = 2048; nt = ct - 120; }
        else if (ct < 232) { W = p.in[21]; WT = (bf16_t*)(p.ws + WS_WT_IN1); N = 5120; nt = ct - 152; }
        else { W = p.in[22]; WT = (bf16_t*)(p.ws + WS_WT_OUT1); N = 2048; nt = ct - 232; }
        const int r = tid >> 4, c4 = (tid & 15) * 4;
#pragma unroll
        for (int itr = 0; itr < 4; ++itr) { const int kk = itr * 32 + r; const f32x4 v = *(const f32x4*)(W + (size_t)(kt * 128 + kk) * N + nt * 64 + c4);
#pragma unroll
            for (int e = 0; e < 4; ++e) T[(c4 + e) * 136 + kk] = f2bf(v[e]); }
        __syncthreads();
        { const int n = tid >> 3, k16 = (tid & 7) * 16; bf16_t* dst = WT + (size_t)(nt * 64 + n) * 2048 + kt * 128 + k16;
          *(u32x4*)dst = *(const u32x4*)(T + n * 136 + k16); *(u32x4*)(dst + 8) = *(const u32x4*)(T + n * 136 + k16 + 8); }
        __syncthreads();
    }
}
__device__ __forceinline__ void phase_prologue(const Params& p, char* lds) {
    const int tid = threadIdx.x, c = (int)blockIdx.x;
    if (c < 96) mod_gemv(p, lds, 0, c, 96);
    if (c == (int)gridDim.x - 1) {
        for (int idx = tid; idx < 2048; idx += 512) { const float g0 = p.in[9][idx], g1 = p.in[9][2048 + idx], g2 = p.in[9][4096 + idx];
            const float m = fmaxf(g0, fmaxf(g1, g2)); const float e0 = __expf(g0 - m), e1 = __expf(g1 - m), e2 = __expf(g2 - m);
            ((float*)(p.ws + WS_LB))[idx] = e0 / (e0 + e1 + e2); }
    }
    if (c < 96) wt_tasks(p, lds, c * 5, 5); else wt_tasks(p, lds, 480 + (c - 96) * 9, 9);
}
__device__ __forceinline__ void tail_fill_p2(const Params& p, char* lds) {
    const int idx = (int)blockIdx.x - 96; if (idx < 0) return;
    if (idx < 96) { mod_gemv(p, lds, 1, idx, 96); wt_tasks(p, lds, 1920 + idx * 10, 10); }
    else wt_tasks(p, lds, 1920 + 960 + (idx - 96) * 13, 13);
}
__device__ __forceinline__ void tail_fill_p6(const Params& p, char* lds) {
    const int idx = (int)blockIdx.x - 128; if (idx < 0) return;
    wt_tasks(p, lds, 3712 + idx * 4, 4);
}

__device__ __forceinline__ void phase_norm(const float* xa, const float* xb, const float* g, const float* mod, bf16_t* H) {
    const int lane = threadIdx.x & 63, gw = blockIdx.x * 8 + (threadIdx.x >> 6), nw = gridDim.x * 8;
#define NCOL(i) ((((i) >> 1) * 64 + lane) * 8 + ((i) & 1) * 4)
    for (int row = gw; row < NTOK; row += 2 * nw) {
        const int row2 = row + nw; const bool has2 = row2 < NTOK; const int r2 = has2 ? row2 : row;
        const float* src = row < NPTOK ? xa + (size_t)row * 2048 : xb + (size_t)(row - NPTOK) * 2048;
        const float* src2 = r2 < NPTOK ? xa + (size_t)r2 * 2048 : xb + (size_t)(r2 - NPTOK) * 2048;
        f32x4 v[8], v2[8]; float ss = 0.f, ss2 = 0.f;
#pragma unroll
        for (int i = 0; i < 8; ++i) v[i] = *(const f32x4*)(src + NCOL(i));
#pragma unroll
        for (int i = 0; i < 8; ++i) v2[i] = *(const f32x4*)(src2 + NCOL(i));
#pragma unroll
        for (int i = 0; i < 8; ++i) ss += v[i][0] * v[i][0] + v[i][1] * v[i][1] + v[i][2] * v[i][2] + v[i][3] * v[i][3];
#pragma unroll
        for (int i = 0; i < 8; ++i) ss2 += v2[i][0] * v2[i][0] + v2[i][1] * v2[i][1] + v2[i][2] * v2[i][2] + v2[i][3] * v2[i][3];
        ss = wave_sum(ss); ss2 = wave_sum(ss2);
        const float rstd = rsqrtf(ss * (1.f / 2048.f) + 1e-6f), rstd2 = rsqrtf(ss2 * (1.f / 2048.f) + 1e-6f);
        const int j = row < NPTOK ? 0 : 1 + ((row - NPTOK) >> 11), j2 = r2 < NPTOK ? 0 : 1 + ((r2 - NPTOK) >> 11);
        const float* sh = mod + j * 6144; const float* sc = sh + 2048; const float* sh2 = mod + j2 * 6144; const float* sc2 = sh2 + 2048;
#pragma unroll
        for (int ip = 0; ip < 4; ++ip) { const int col = (ip * 64 + lane) * 8;
            const f32x4 ga = *(const f32x4*)(g + col), gb = *(const f32x4*)(g + col + 4);
            { const f32x4 ya = v[2 * ip] * rstd * ga * (*(const f32x4*)(sc + col) + 1.f) + *(const f32x4*)(sh + col), yb = v[2 * ip + 1] * rstd * gb * (*(const f32x4*)(sc + col + 4) + 1.f) + *(const f32x4*)(sh + col + 4);
              const u32x4 w = {cvt_pk_bf16(ya[0], ya[1]), cvt_pk_bf16(ya[2], ya[3]), cvt_pk_bf16(yb[0], yb[1]), cvt_pk_bf16(yb[2], yb[3])}; *(u32x4*)(H + (size_t)row * 2048 + col) = w; }
            if (has2) { const f32x4 ya = v2[2 * ip] * rstd2 * ga * (*(const f32x4*)(sc2 + col) + 1.f) + *(const f32x4*)(sh2 + col), yb = v2[2 * ip + 1] * rstd2 * gb * (*(const f32x4*)(sc2 + col + 4) + 1.f) + *(const f32x4*)(sh2 + col + 4);
              const u32x4 w = {cvt_pk_bf16(ya[0], ya[1]), cvt_pk_bf16(ya[2], ya[3]), cvt_pk_bf16(yb[0], yb[1]), cvt_pk_bf16(yb[2], yb[3])}; *(u32x4*)(H + (size_t)row2 * 2048 + col) = w; } }
    }
#undef NCOL
}

template <int LAYER>
__device__ __forceinline__ void phase_prep(const Params& p) {
    constexpr int LDU = LAYER ? LDU1 : LDU0, QOFF = LAYER ? 0 : 5120, NQH = LAYER ? 16 : 8, KOFF_ = LAYER ? 2048 : 6144, NKH = LAYER ? 4 : 2;
    constexpr int NQS = NQH / 4, NKS = (2 * NKH) / 4;
    const float* qn = p.in[LAYER ? 23 : 16]; const float* kn = p.in[LAYER ? 24 : 17];
    float* outk = p.out + (LAYER ? OUT_L1K : OUT_L0K); float* outv = p.out + (LAYER ? OUT_L1V : OUT_L0V);
    const float* ck = p.in[LAYER ? 5 : 3]; const float* cv = p.in[LAYER ? 6 : 4];
    bf16_t* U = (bf16_t*)(p.ws + WS_U); bf16_t* KS = (bf16_t*)(p.ws + WS_KS); bf16_t* VS = (bf16_t*)(p.ws + WS_VS); bf16_t* KP = (bf16_t*)(p.ws + WS_KP); bf16_t* VP = (bf16_t*)(p.ws + WS_VP);
    const int lane = threadIdx.x & 63, gw = blockIdx.x * 8 + (threadIdx.x >> 6), nw = gridDim.x * 8;
    const int sub = lane >> 4, l16 = lane & 15, c8 = l16 * 8, a = (l16 >> 3) & 1, i0 = (l16 & 3) * 8;
    const float sgn = ((l16 >> 2) & 1) ? 1.f : -1.f;
    float qw[8], kw[8], inv[8];
#pragma unroll
    for (int j = 0; j < 8; ++j) { qw[j] = qn[c8 + j]; kw[j] = kn[c8 + j]; inv[j] = exp2f(-(float)(i0 + j) * (13.287712379549449f / 32.f)) * 0.15915494309189535f; }
    for (int tok = gw; tok < NTOK; tok += nw) {
        const bool samp = tok >= NPTOK; int b, t; if (samp) { b = (tok - NPTOK) >> 11; t = (tok - NPTOK) & 2047; } else { b = tok >> 8; t = tok & 255; }
        bf16_t* u = U + (size_t)tok * LDU + c8;
        bf16x8 xq[NQS], xkv[NKS];
#pragma unroll
        for (int s_ = 0; s_ < NQS; ++s_) xq[s_] = *(const bf16x8*)(u + QOFF + (s_ * 4 + sub) * 128);
#pragma unroll
        for (int s_ = 0; s_ < NKS; ++s_) xkv[s_] = *(const bf16x8*)(u + KOFF_ + (s_ * 4 + sub) * 128);
        float cs[8], sn[8];
#pragma unroll
        for (int j = 0; j < 8; ++j) { cs[j] = 1.f; sn[j] = 0.f; }
        if (samp) { const float pos = (float)(a ? (t & 63) : (t >> 6));
#pragma unroll
            for (int j = 0; j < 8; ++j) { float r = pos * inv[j]; r -= floorf(r); sn[j] = __builtin_amdgcn_sinf(r) * sgn; cs[j] = __builtin_amdgcn_cosf(r); } }
#pragma unroll
        for (int s_ = 0; s_ < NQS; ++s_) { float y[8], ss = 0.f;
#pragma unroll
            for (int j = 0; j < 8; ++j) { y[j] = bf2f((bf16_t)xq[s_][j]); ss += y[j] * y[j]; }
            ss += __shfl_xor(ss, 1); ss += __shfl_xor(ss, 2); ss += __shfl_xor(ss, 4); ss += __shfl_xor(ss, 8);
            const float rstd = rsqrtf(ss * (1.f / 128.f) + 1e-6f);
#pragma unroll
            for (int j = 0; j < 8; ++j) y[j] *= rstd * qw[j];
            float o[8];
#pragma unroll
            for (int j = 0; j < 8; ++j) o[j] = y[j] * cs[j] + __shfl_xor(y[j], 4) * sn[j];
            const u32x4 w = {cvt_pk_bf16(o[0], o[1]), cvt_pk_bf16(o[2], o[3]), cvt_pk_bf16(o[4], o[5]), cvt_pk_bf16(o[6], o[7])};
            *(u32x4*)(u + QOFF + (s_ * 4 + sub) * 128) = w; }
#pragma unroll
        for (int s_ = 0; s_ < NKS; ++s_) { const int slot = s_ * 4 + sub; const bool isk = slot < NKH; const int h = isk ? slot : slot - NKH;
            float x[8], y[8], ss = 0.f;
#pragma unroll
            for (int j = 0; j < 8; ++j) { x[j] = bf2f((bf16_t)xkv[s_][j]); ss += x[j] * x[j]; }
            ss += __shfl_xor(ss, 1); ss += __shfl_xor(ss, 2); ss += __shfl_xor(ss, 4); ss += __shfl_xor(ss, 8);
            const float rstd = rsqrtf(ss * (1.f / 128.f) + 1e-6f);
#pragma unroll
            for (int j = 0; j < 8; ++j) y[j] = x[j] * rstd * kw[j];
            float o[8];
#pragma unroll
            for (int j = 0; j < 8; ++j) { const float z = __shfl_xor(y[j], 4); o[j] = isk ? (y[j] * cs[j] + z * sn[j]) : x[j]; }
            const u32x4 w = {cvt_pk_bf16(o[0], o[1]), cvt_pk_bf16(o[2], o[3]), cvt_pk_bf16(o[4], o[5]), cvt_pk_bf16(o[6], o[7])};
            if (!samp) { float* of = (isk ? outk : outv) + ((size_t)tok * NKH + h) * 128 + c8;
                *(f32x4*)of = (f32x4){o[0], o[1], o[2], o[3]}; *(f32x4*)(of + 4) = (f32x4){o[4], o[5], o[6], o[7]};
                *(u32x4*)((isk ? KP : VP) + ((size_t)(b * NKH + h) * 256 + t) * 128 + c8) = w; }
            else *(u32x4*)((isk ? KS : VS) + ((size_t)(b * NKH + h) * 2304 + t) * 128 + c8) = w; }
    }
    for (int r4 = gw * 4; r4 < 8 * 256 * NKH; r4 += nw * 4) { const int r = r4 + sub; const int b = r / (256 * NKH), j = (r / NKH) & 255, h = r % NKH;
        const size_t o = ((size_t)(b * NKH + h) * 2304 + 2048 + j) * 128 + c8;
        const f32x4 k0 = *(const f32x4*)(ck + (size_t)r * 128 + c8), k1 = *(const f32x4*)(ck + (size_t)r * 128 + c8 + 4), v0 = *(const f32x4*)(cv + (size_t)r * 128 + c8), v1 = *(const f32x4*)(cv + (size_t)r * 128 + c8 + 4);
        const u32x4 wk = {cvt_pk_bf16(k0[0], k0[1]), cvt_pk_bf16(k0[2], k0[3]), cvt_pk_bf16(k1[0], k1[1]), cvt_pk_bf16(k1[2], k1[3])};
        const u32x4 wv = {cvt_pk_bf16(v0[0], v0[1]), cvt_pk_bf16(v0[2], v0[3]), cvt_pk_bf16(v1[0], v1[1]), cvt_pk_bf16(v1[2], v1[3])};
        *(u32x4*)(KS + o) = wk; *(u32x4*)(VS + o) = wv; }
}

__device__ __forceinline__ void phase_comb0(const Params& p) {
    const bf16_t* U = (const bf16_t*)(p.ws + WS_U); bf16_t* MIX = (bf16_t*)(p.ws + WS_H);
    const int lane = threadIdx.x & 63, gw = blockIdx.x * 8 + (threadIdx.x >> 6), nw = gridDim.x * 8;
    const int sub = lane >> 4, c8 = (lane & 15) * 8;
    const f32x4 onA = *(const f32x4*)(p.in[15] + c8), onB = *(const f32x4*)(p.in[15] + c8 + 4);
    for (int tok = gw; tok < NTOK; tok += 2 * nw) {
        const int tok2 = tok + nw; const bool has2 = tok2 < NTOK;
        bf16x8 vf[4], vb[4], vg[4];
#pragma unroll
        for (int q = 0; q < 4; ++q) { const int tk = (q < 2 || has2) ? ((q < 2) ? tok : tok2) : tok; const bf16_t* u = U + (size_t)tk * LDU0 + ((q & 1) * 4 + sub) * 128 + c8;
            vf[q] = *(const bf16x8*)(u + 1024); vb[q] = *(const bf16x8*)(u + 2048); vg[q] = *(const bf16x8*)(u + 4096); }
#pragma unroll
        for (int q = 0; q < 4; ++q) { if (q >= 2 && !has2) break;
            float sv[8], ss = 0.f;
#pragma unroll
            for (int j = 0; j < 8; ++j) { sv[j] = bf2f((bf16_t)vf[q][j]) + bf2f((bf16_t)vb[q][j]); ss += sv[j] * sv[j]; }
            ss += __shfl_xor(ss, 1); ss += __shfl_xor(ss, 2); ss += __shfl_xor(ss, 4); ss += __shfl_xor(ss, 8);
            const float rstd = rsqrtf(ss * (1.f / 128.f) + 1e-6f);
            float f[8];
#pragma unroll
            for (int j = 0; j < 8; ++j) f[j] = sv[j] * rstd * (j < 4 ? onA[j] : onB[j - 4]) * siluf(bf2f((bf16_t)vg[q][j]));
            const u32x4 w = {cvt_pk_bf16(f[0], f[1]), cvt_pk_bf16(f[2], f[3]), cvt_pk_bf16(f[4], f[5]), cvt_pk_bf16(f[6], f[7])};
            const int tk = q < 2 ? tok : tok2;
            *(u32x4*)(MIX + (size_t)tk * 2048 + ((q & 1) * 4 + sub) * 128 + c8) = w; }
    }
}

__device__ __forceinline__ void attn0_run(const Params& p, char* lds, bool samp, int b, int h, int qb) {
    char* ws = p.ws; asm volatile("" : "+s"(ws));
    const bf16_t* U = (const bf16_t*)(ws + WS_U); bf16_t* MIX = (bf16_t*)(ws + WS_H); const int kvh = h >> 2;
    const size_t row = samp ? NPTOK + (size_t)b * 2048 + qb * 256 : (size_t)b * 256;
    const size_t kvo = samp ? (size_t)(b * 2 + kvh) * 2304 * 128 : (size_t)(b * 2 + kvh) * 256 * 128;
    const bf16_t* Kp = (const bf16_t*)(ws + (samp ? WS_KS : WS_KP)) + kvo; const bf16_t* Vp = (const bf16_t*)(ws + (samp ? WS_VS : WS_VP)) + kvo;
    attn_body<LDU0>(U + row * LDU0 + 5120 + h * 128, Kp, Vp, U + row * LDU0 + 6656 + h * 128, MIX + row * 2048 + 1024 + h * 128,
                    samp ? 36 : 4, samp ? 4 : 0, samp ? 2048 : 0, 0, false, qb * 256, nullptr, lds);
}
__device__ __forceinline__ void attn_item1(const Params& p, char* lds, int a) {
    char* ws = p.ws; asm volatile("" : "+s"(ws));
    const bf16_t* U = (const bf16_t*)(ws + WS_U); bf16_t* MIX = (bf16_t*)(ws + WS_H);
    const bool samp = a < 1024;
    int b, kvh, h0, i0, ls, le; size_t row, kvo;
    if (samp) { const int x_ = a & 7, tb = (a >> 3) & 31, set_ = x_ + 8 * (a >> 8);
        b = set_ >> 2; kvh = set_ & 3; h0 = kvh * 4; i0 = tb * 64; row = NPTOK + (size_t)b * 2048 + i0; kvo = (size_t)(b * 4 + kvh) * 2304 * 128;
        ls = tb - 2 < 0 ? 0 : tb - 2; le = tb + 3 > 32 ? 32 : tb + 3;
    } else { const int a2 = a - 1024; b = a2 >> 4; h0 = a2 & 15; kvh = h0 >> 2; i0 = 0; row = (size_t)b * 256; kvo = (size_t)(b * 4 + kvh) * 256 * 128; ls = 0; le = 4; }
    const bf16_t* Kp = (const bf16_t*)(ws + (samp ? WS_KS : WS_KP)) + kvo; const bf16_t* Vp = (const bf16_t*)(ws + (samp ? WS_VS : WS_VP)) + kvo;
    attn_body<LDU1>(U + row * LDU1 + h0 * 128, Kp, Vp, U + row * LDU1 + 3072 + h0 * 128, MIX + row * 2048 + h0 * 128,
                    samp ? 4 + le - ls : 4, samp ? 4 : 0, samp ? 2048 : 0, ls, samp, i0, p.in[25] + h0, lds, samp);
}

template <class Epi>
__device__ __forceinline__ void phase_gemm(unsigned char* shm, const bf16_t* A, const bf16_t* Bt, int N, const Epi& E) {
    Gemm g; g.A = A; g.Bt = Bt; g.M = NTOK; g.N = N; g.K = 2048;
    StaticOrder S; S.init(NTOK, N, (int)gridDim.x, (int)blockIdx.x);
    gemm_phase<Epi, StaticOrder, false>((PG8_LAS unsigned char*)shm, g, S, E, nullptr);
}

#define XB_TMO      128
#define XB_XCNT(j)  (256  + 64 * (j))
#define XB_XSUB(j)  (1280 + 64 * (j))
#define XB_XGEN(j)  (2304 + 64 * (j))
#define XB_TOP      3328
#define XB_TOPGEN   3392
#define XCD_BAR_WORDS 3456
#define XB_SPIN_CAP (1u << 18)
#define LAS __attribute__((address_space(3)))

__device__ __forceinline__ unsigned xb_ld(unsigned* p)              { return __hip_atomic_load(p, __ATOMIC_RELAXED, __HIP_MEMORY_SCOPE_AGENT); }
__device__ __forceinline__ unsigned xb_add(unsigned* p, unsigned v) { return __hip_atomic_fetch_add(p, v, __ATOMIC_RELAXED, __HIP_MEMORY_SCOPE_AGENT); }
__device__ __forceinline__ unsigned xb_xcc_id() { return (unsigned)__builtin_amdgcn_s_getreg((3 << 11) | 20) & 0xFu; }
#define XB_SPIN(cond, bar) do { unsigned _sp = 0; while (cond) { __builtin_amdgcn_s_sleep(1); \
    if ((++_sp & 255u) == 0u) { if (xb_ld(&(bar)[XB_TMO])) break; if (_sp > XB_SPIN_CAP) { atomicAdd(&(bar)[XB_TMO], 1u); break; } } } } while (0)

struct XcdBarrier {
    unsigned* bar; unsigned x;
    volatile LAS unsigned* st;
};

__device__ __forceinline__ XcdBarrier xcd_barrier_post(unsigned* bar, volatile LAS unsigned* st) {
    XcdBarrier b; b.bar = bar; b.x = xb_xcc_id(); b.st = st;
    if (threadIdx.x == 0) (void)xb_add(&bar[XB_XCNT(b.x)], 1u);
    return b;
}
__device__ __forceinline__ void xcd_barrier_complete(unsigned* bar, unsigned x, unsigned& nloc, unsigned& nx) {
    const unsigned G = gridDim.x * gridDim.y * gridDim.z;
    unsigned sum, cnt, mine, sp = 0u;
    for (;;) {
        sum = 0u; cnt = 0u; mine = 0u;
#pragma unroll
        for (unsigned j = 0; j < 16; ++j) { const unsigned c = xb_ld(&bar[XB_XCNT(j)]); sum += c; cnt += (c > 0u) ? 1u : 0u; mine = (j == x) ? c : mine; }
        if (sum == G) break;
        __builtin_amdgcn_s_sleep(1);
        if ((++sp & 255u) == 0u) { if (xb_ld(&bar[XB_TMO])) break; if (sp > XB_SPIN_CAP) { atomicAdd(&bar[XB_TMO], 1u); break; } }
    }
    nloc = mine > 0u ? mine : 1u; nx = cnt > 0u ? cnt : 1u;
}

__device__ __forceinline__ void xcd_barrier(const XcdBarrier& b) {
    asm volatile("s_waitcnt vmcnt(0)" ::: "memory");
    __syncthreads();
    if (threadIdx.x == 0) {
        unsigned* bar = b.bar;
        __builtin_amdgcn_s_waitcnt(0);
        unsigned nloc = b.st[0], nx = b.st[1];
        if (nloc == 0u) { xcd_barrier_complete(bar, b.x, nloc, nx); b.st[0] = nloc; b.st[1] = nx; }
        const unsigned old = xb_add(&bar[XB_XSUB(b.x)], 1u);
        const unsigned gen = old / nloc;
        if (old + 1u == (gen + 1u) * nloc) {
            __builtin_amdgcn_fence(__ATOMIC_RELEASE, "agent");
            asm volatile("s_waitcnt vmcnt(0)" ::: "memory");
            const unsigned og = xb_add(&bar[XB_TOP], 1u);
            const unsigned tg = og / nx;
            if (og + 1u == (tg + 1u) * nx) xb_add(&bar[XB_TOPGEN], 1u);
            else XB_SPIN(xb_ld(&bar[XB_TOPGEN]) == tg, bar);
            __builtin_amdgcn_fence(__ATOMIC_ACQUIRE, "agent");
            xb_add(&bar[XB_XGEN(b.x)], 1u);
            asm volatile("s_waitcnt vmcnt(0)" ::: "memory");
        } else {
            XB_SPIN(xb_ld(&bar[XB_XGEN(b.x)]) == gen, bar);
            __builtin_amdgcn_fence(__ATOMIC_ACQUIRE, "agent");
            asm volatile("s_waitcnt vmcnt(0)" ::: "memory");
        }
    }
    __syncthreads();
}


constexpr int NPHASE = 12;
#define XB_NOW() do { XcdBarrier b_; b_.bar = (unsigned*)(p.ws + WS_BAR); b_.x = xb_xcc_id(); b_.st = (volatile LAS unsigned*)(shm + LDS_BYTES); xcd_barrier(b_); } while (0)
#if MK_MULTI
#define GSYNC(n) do { if (ph0 <= (n) && (n) + 1 < ph1) XB_NOW(); } while (0)
#define PH_ON(n) (ph0 <= (n) && (n) < ph1)
#else
#define GSYNC(n) do { if (ph0 <= (n) && (n) + 1 < ph1) XB_NOW(); } while (0)
#define PH_ON(n) (ph0 <= (n) && (n) < ph1)
#endif
__global__ void __launch_bounds__(512) mega(Params p, int ph0, int ph1) {
    extern __shared__ __attribute__((aligned(16))) unsigned char shm[];
    char* lds = (char*)shm;
    volatile LAS unsigned* xst = (volatile LAS unsigned*)(shm + LDS_BYTES);
    if (threadIdx.x == 0) { xst[0] = 0u; xst[1] = 0u; }
    __syncthreads();
    (void)xcd_barrier_post((unsigned*)(p.ws + WS_BAR), xst);
    if (p.ws == nullptr) cg::this_grid().sync();
#if (PHSEL >> 0) & 1
    if (PH_ON(0)) for (int rep = 0; rep <= ((REPMASK >> 0) & 1); ++rep) { if (rep) XB_NOW(); phase_prologue(p, lds);
        }
    GSYNC(0);
#endif
#if (PHSEL >> 1) & 1
    if (PH_ON(1)) for (int rep = 0; rep <= ((REPMASK >> 1) & 1); ++rep) { if (rep) XB_NOW(); phase_norm(p.in[0], p.in[1], p.in[10], (const float*)(p.ws + WS_MOD), (bf16_t*)(p.ws + WS_H));
        }
    GSYNC(1);
#endif
#if (PHSEL >> 2) & 1
    if (PH_ON(2)) for (int rep = 0; rep <= ((REPMASK >> 2) & 1); ++rep) { if (rep) XB_NOW(); { EpiU E; E.O = (bf16_t*)(p.ws + WS_U); E.ldc = LDU0; phase_gemm(shm, (const bf16_t*)(p.ws + WS_H), (const bf16_t*)(p.ws + WS_WT_IN0), 7680, E); }
        if (!rep) tail_fill_p2(p, lds);
        }
    GSYNC(2);
#endif
#if (PHSEL >> 3) & 1
    if (PH_ON(3)) for (int rep = 0; rep <= ((REPMASK >> 3) & 1); ++rep) { if (rep) XB_NOW(); phase_prep<0>(p);
        }
    GSYNC(3);
#endif
#if (PHSEL >> 4) & 1
    if (PH_ON(4)) for (int rep = 0; rep <= ((REPMASK >> 4) & 1); ++rep) { if (rep) XB_NOW();
            unsigned* qctr = (unsigned*)(p.ws + WS_BAR) + 3584;
            volatile LAS unsigned* slot = (volatile LAS unsigned*)(shm + LDS_BYTES + 8);
            const unsigned x0 = xb_xcc_id() & 7u;
            for (unsigned xo = 0; xo < 8u; ++xo) { const unsigned x = (x0 + xo) & 7u;
                for (;;) {
                    __syncthreads();
                    if (threadIdx.x == 0) *slot = __hip_atomic_fetch_add(qctr + 64 * x, 1u, __ATOMIC_RELAXED, __HIP_MEMORY_SCOPE_AGENT);
                    __syncthreads();
                    const int q = (int)*slot;
                    if (q >= 128 || rep) break;
                    if (q < 16 || (q >= 80 && q < 112)) hgrn_chain(p, lds, q < 16 ? (int)x * 16 + q : 128 + (int)x * 32 + (q - 80));
                    else if (q < 80) { const int j = q - 16, set_ = (int)x + 8 * (j >> 5), li = j & 31; attn0_run(p, lds, true, set_ >> 1, (set_ & 1) * 4 + (li >> 3), li & 7); }
                    else { const int a2 = (int)x * 16 + (q - 112); attn0_run(p, lds, false, a2 >> 3, a2 & 7, 0); }
                }
            }

        }
    GSYNC(4);
#endif
#if (PHSEL >> 5) & 1
    if (PH_ON(5)) for (int rep = 0; rep <= ((REPMASK >> 5) & 1); ++rep) { if (rep) XB_NOW(); phase_comb0(p);
        }
    GSYNC(5);
#endif
#if (PHSEL >> 6) & 1
    if (PH_ON(6)) for (int rep = 0; rep <= ((REPMASK >> 6) & 1); ++rep) { if (rep) XB_NOW(); { EpiRes E; E.Y = p.out; E.xp = p.in[0]; E.xs = p.in[1]; E.mod = (const float*)(p.ws + WS_MOD);
                  phase_gemm(shm, (const bf16_t*)(p.ws + WS_H), (const bf16_t*)(p.ws + WS_WT_OUT0), 2048, E); }
        if (!rep) tail_fill_p6(p, lds);
        }
    GSYNC(6);
#endif
#if (PHSEL >> 7) & 1
    if (PH_ON(7)) for (int rep = 0; rep <= ((REPMASK >> 7) & 1); ++rep) { if (rep) XB_NOW(); phase_norm(p.out, p.out + (size_t)NPTOK * 2048, p.in[18], (const float*)(p.ws + WS_MOD) + 9 * 6144, (bf16_t*)(p.ws + WS_H));
        }
    GSYNC(7);
#endif
#if (PHSEL >> 8) & 1
    if (PH_ON(8)) for (int rep = 0; rep <= ((REPMASK >> 8) & 1); ++rep) { if (rep) XB_NOW(); { EpiU E; E.O = (bf16_t*)(p.ws + WS_U); E.ldc = LDU1; phase_gemm(shm, (const bf16_t*)(p.ws + WS_H), (const bf16_t*)(p.ws + WS_WT_IN1), 5120, E); }
        }
    GSYNC(8);
#endif
#if (PHSEL >> 9) & 1
    if (PH_ON(9)) for (int rep = 0; rep <= ((REPMASK >> 9) & 1); ++rep) { if (rep) XB_NOW(); phase_prep<1>(p);
        }
    GSYNC(9);
#endif
#if (PHSEL >> 10) & 1
    if (PH_ON(10)) for (int rep = 0; rep <= ((REPMASK >> 10) & 1); ++rep) { if (rep) XB_NOW();
            for (int item = blockIdx.x; item < 1280; item += gridDim.x) { __syncthreads(); attn_item1(p, lds, item); }

        }
    GSYNC(10);
#endif
#if (PHSEL >> 11) & 1
    if (PH_ON(11)) for (int rep = 0; rep <= ((REPMASK >> 11) & 1); ++rep) { if (rep) XB_NOW(); { EpiRes E; E.Y = p.out; E.xp = p.out; E.xs = p.out + (size_t)NPTOK * 2048; E.mod = (const float*)(p.ws + WS_MOD) + 9 * 6144;
                   phase_gemm(shm, (const bf16_t*)(p.ws + WS_H), (const bf16_t*)(p.ws + WS_WT_OUT1), 2048, E); }
        }
    GSYNC(11);
#endif
}

extern "C" void kernel_launch(void* const* d_in, const int* in_sizes, int n_in, void* d_out, int out_size, void* d_ws, size_t ws_size, hipStream_t stream) {
    static int grid_blocks = 0;
    if (!grid_blocks) {
        if (ws_size < WS_END) { fprintf(stderr, "workspace too small: %zu < %zu\n", ws_size, WS_END); return; }
        if (hipFuncSetAttribute((const void*)mega, hipFuncAttributeMaxDynamicSharedMemorySize, LDS_BYTES + 16) != hipSuccess) { fprintf(stderr, "hipFuncSetAttribute failed\n"); return; }
        int dev = 0, cus = 0, per_cu = 0;
        hipGetDevice(&dev);
        hipDeviceGetAttribute(&cus, hipDeviceAttributeMultiprocessorCount, dev);
        hipOccupancyMaxActiveBlocksPerMultiprocessor(&per_cu, mega, 512, LDS_BYTES + 16);
        if (per_cu < 1) { fprintf(stderr, "occupancy query returned %d\n", per_cu); return; }
        if (cus != 256) { fprintf(stderr, "this kernel's static work split assumes 256 CUs (MI355X), found %d\n", cus); return; }
        grid_blocks = 256;
    }
    Params p{};
    for (int i = 0; i < 26; ++i) p.in[i] = (const float*)d_in[i];
    p.out = (float*)d_out; p.ws = (char*)d_ws;
    hipMemsetAsync((char*)d_ws + WS_BAR, 0, 16384, stream);
#if MK_MULTI
    for (int ph = 0; ph < NPHASE; ++ph) hipLaunchKernelGGL(mega, dim3(grid_blocks), dim3(512), LDS_BYTES + 16, stream, p, ph, ph + 1);
#else
    int ph0 = 0, ph1 = NPHASE;
    void* args[] = {&p, &ph0, &ph1};
    hipError_t e = hipLaunchCooperativeKernel((void*)mega, dim3(grid_blocks), dim3(512), args, LDS_BYTES + 16, stream);
    if (e != hipSuccess) fprintf(stderr, "cooperative launch failed: %s (grid %d)\n", hipGetErrorString(e), grid_blocks);
#endif
}
```

```cpp
#include <hip/hip_runtime.h>
#include <hip/hip_cooperative_groups.h>
#include <cstdio>
#include <cstdint>
namespace cg = cooperative_groups;

#ifndef PHSEL
#define PHSEL 0xFFF
#endif
#ifndef REPMASK
#define REPMASK 0
#endif
#ifndef MK_MULTI
#define MK_MULTI 0
#endif

constexpr int NTOK = 20480, NPTOK = 4096, DM = 2048;
constexpr int LDU0 = 7680, LDU1 = 5120;
constexpr size_t WS_WT_IN0 = 0;
constexpr size_t WS_WT_OUT0 = WS_WT_IN0 + (size_t)7680 * 2048 * 2;
constexpr size_t WS_WT_IN1 = WS_WT_OUT0 + (size_t)2048 * 2048 * 2;
constexpr size_t WS_WT_OUT1 = WS_WT_IN1 + (size_t)5120 * 2048 * 2;
constexpr size_t WS_MOD = WS_WT_OUT1 + (size_t)2048 * 2048 * 2;
constexpr size_t WS_LB = WS_MOD + (size_t)2 * 9 * 6144 * 4;
constexpr size_t WS_H = WS_LB + 8192;
constexpr size_t WS_U = WS_H + (size_t)NTOK * 2048 * 2;
constexpr size_t WS_KS = WS_U + (size_t)NTOK * 7680 * 2;
constexpr size_t WS_VS = WS_KS + (size_t)8 * 4 * 2304 * 128 * 2;
constexpr size_t WS_KP = WS_VS + (size_t)8 * 4 * 2304 * 128 * 2;
constexpr size_t WS_VP = WS_KP + (size_t)16 * 4 * 256 * 128 * 2;
constexpr size_t WS_BAR = WS_VP + (size_t)16 * 4 * 256 * 128 * 2;
constexpr size_t WS_END = WS_BAR + 16384;
constexpr size_t OUT_STATE = 41943040, OUT_L0K = 46137344, OUT_L0V = 47185920, OUT_L1K = 48234496, OUT_L1V = 50331648;
constexpr int O_LDS_OFF = 67584;
constexpr int LDS_BYTES = 2 * 38400 + 2 * 8704 + 6 * 8704;

struct Params { const float* in[26]; float* out; char* ws; };

namespace pg8 {
#define PG8_LAS __attribute__((address_space(3)))
typedef unsigned short bf16_t;
typedef short bf16x8 __attribute__((ext_vector_type(8)));
typedef float f32x4 __attribute__((ext_vector_type(4)));
typedef unsigned u32x4 __attribute__((ext_vector_type(4)));
constexpr int BM = 256, BK = 64, HALF = 128, HTB = HALF * BK * 2  , STAGE_BYTES = 8 * HTB, NXCD = 8, WGM = 8;

__host__ __device__ __forceinline__ int lds_byte(int r, int c) { const int st = (r >> 4) * 2 + (c >> 5), rr = r & 15, cc = c & 31, ob = rr * 64 + cc * 2; return st * 1024 + (ob ^ (((ob >> 9) & 1) << 5)); }
__host__ __device__ __forceinline__ void stage_rc(int b, int& R, int& C) { const int st = b / 1024, sb = b % 1024, swz = sb ^ (((sb >> 9) & 1) << 5); R = (st >> 1) * 16 + swz / 64; C = (st & 1) * 32 + (swz % 64) / 2; }
__host__ __device__ __forceinline__ int perm32(int rho) { const int n = rho >> 4, i = rho & 15; return 8 * (i >> 2) + 4 * n + (i & 3); }

struct Unit { int pm, pn; };
struct Gemm { const bf16_t* A; const bf16_t* Bt; int M, N, K; };

struct StaticOrder {
    int nM, nN, nwg, G, c;
    __host__ __device__ void init(int M, int N, int G_, int c_) { nM = M / BM; nN = N / BM; nwg = nM * nN; G = G_; c = c_; }
    __host__ __device__ bool next(int i, Unit& u) const {
        const long L = (long)i * G + c; if (L >= nwg) return false;
        int wgid = (int)L; { const int q = nwg / NXCD, r = nwg % NXCD, xcd = wgid % NXCD, off = wgid / NXCD; wgid = (xcd < r ? xcd * (q + 1) : r * (q + 1) + (xcd - r) * q) + off; }
        const int nig = WGM * nN, gid = wgid / nig, fm = gid * WGM, gsz = (nM - fm) < WGM ? (nM - fm) : WGM;
        u.pm = fm + ((wgid % nig) % gsz); u.pn = (wgid % nig) / gsz; return true;
    }
    __device__ __forceinline__ void a_ready(const Unit&) const {}
    __device__ __forceinline__ void done(const Unit&) const {}
};
__device__ __forceinline__ unsigned cvt_pk_bf16(float lo, float hi) { unsigned r; asm volatile("v_cvt_pk_bf16_f32 %0, %1, %2" : "=v"(r) : "v"(lo), "v"(hi)); return r; }


template <class Epi, class Sched, bool STAMP = false>
__device__ __forceinline__ void gemm_phase(PG8_LAS unsigned char* lds, const Gemm g, const Sched& S, const Epi& E, unsigned long long* stamps) {
    const int tid = threadIdx.x, wid = __builtin_amdgcn_readfirstlane(tid >> 6), lane = tid & 63, wr = wid >> 2, wc = wid & 3, fr = lane & 15, fq = lane >> 4;
    const int K = g.K, nt = K / BK;
    int ts_lo = 0, ts_hi = 0, nts = 0; const unsigned long long rt_entry = STAMP ? (unsigned long long)wall_clock64() : 0ull;
#define PG8_STAMP() do { if (STAMP && wid == 0 && nts < 64) { const unsigned long long _c = (unsigned long long)clock64(); \
        ts_lo = (lane == nts) ? (int)(unsigned)_c : ts_lo; ts_hi = (lane == nts) ? (int)(unsigned)(_c >> 32) : ts_hi; ++nts; } } while (0)
    PG8_STAMP();
    unsigned voffA[2], voffB[2];
#pragma unroll
    for (int i = 0; i < 2; ++i) { int R, C; stage_rc(tid * 16 + i * 8192, R, C); const int Rb = Epi::PERM ? ((R & ~31) + perm32(R & 31)) : R;
        voffA[i] = (unsigned)(R * K + C) * 2u; voffB[i] = (unsigned)(Rb * K + C) * 2u; }
    const size_t kstep = (size_t)(BK * 2);
    const size_t hstep = (size_t)HALF * K * 2;
    const size_t tstep = 2 * hstep;
    const unsigned ldsw = (unsigned)wid * 1024u;
    const int aoff = lds_byte(wr * 64 + fr, fq * 8), boff = lds_byte(wc * 32 + fr, fq * 8);
#define PG8_SA(b, h) (((b) * 2 + (h)) * HTB)
#define PG8_SB(b, h) ((4 + (b) * 2 + (h)) * HTB)
#define PG8_STAGE(bufoff, gbase, voff) do { _Pragma("unroll") for (int _i = 0; _i < 2; ++_i) \
        __builtin_amdgcn_global_load_lds((const unsigned*)((const char*)(gbase) + (voff)[_i]), (PG8_LAS unsigned*)(lds + (bufoff) + ldsw + _i * 8192), 16, 0, 0); } while (0)
#define PG8_LDA(dst, b, h) do { _Pragma("unroll") for (int m = 0; m < 4; ++m) _Pragma("unroll") for (int k = 0; k < 2; ++k) dst[m][k] = *(const PG8_LAS bf16x8*)(lds + PG8_SA(b, h) + aoff + m * 2048 + k * 1024); } while (0)
#define PG8_LDB(dst, b, h) do { _Pragma("unroll") for (int n = 0; n < 2; ++n) _Pragma("unroll") for (int k = 0; k < 2; ++k) dst[n][k] = *(const PG8_LAS bf16x8*)(lds + PG8_SB(b, h) + boff + n * 2048 + k * 1024); } while (0)
#define PG8_MMA(ai, bj, At, Bt) do { __builtin_amdgcn_s_setprio(1); _Pragma("unroll") for (int m = 0; m < 4; ++m) _Pragma("unroll") for (int n = 0; n < 2; ++n) _Pragma("unroll") for (int k = 0; k < 2; ++k) \
        acc[ai][bj][m][n] = __builtin_amdgcn_mfma_f32_16x16x32_bf16(Bt[n][k], At[m][k], acc[ai][bj][m][n], 0, 0, 0); __builtin_amdgcn_s_setprio(0); } while (0)
#define PG8_WAIT_V(n) asm volatile("s_waitcnt vmcnt(" #n ")" ::: "memory")
#define PG8_WAIT_L(n) asm volatile("s_waitcnt lgkmcnt(" #n ")" ::: "memory")
#define PG8_BAR __builtin_amdgcn_s_barrier()
#define PG8_SCHED __builtin_amdgcn_sched_barrier(0)
    Unit cur, nxt; int ui = 0;
    if (!S.next(0, cur)) return;
    f32x4 acc[2][2][4][2];
#pragma unroll
    for (int a = 0; a < 2; ++a)
#pragma unroll
        for (int b = 0; b < 2; ++b)
#pragma unroll
            for (int m = 0; m < 4; ++m)
#pragma unroll
                for (int n = 0; n < 2; ++n) acc[a][b][m][n] = (f32x4){0.f, 0.f, 0.f, 0.f};
    bf16x8 At[4][2], B0[2][2], B1[2][2];
    const char* cA = (const char*)g.A + (size_t)cur.pm * tstep; const char* cB = (const char*)g.Bt + (size_t)cur.pn * tstep;
    S.a_ready(cur);
    PG8_STAGE(PG8_SB(0, 0), cB, voffB); PG8_STAGE(PG8_SA(0, 0), cA, voffA); PG8_STAGE(PG8_SB(0, 1), cB + hstep, voffB); PG8_STAGE(PG8_SA(0, 1), cA + hstep, voffA);
    if (wr == 1) PG8_BAR;
    PG8_WAIT_V(4); PG8_BAR;
    PG8_STAGE(PG8_SB(1, 0), cB + kstep, voffB); PG8_STAGE(PG8_SA(1, 0), cA + kstep, voffA); PG8_STAGE(PG8_SB(1, 1), cB + hstep + kstep, voffB);
    PG8_WAIT_V(6); PG8_BAR;
    PG8_STAMP();
    for (;;) {
        const bool has_next = S.next(ui + 1, nxt);
        const char* nA = has_next ? (const char*)g.A + (size_t)nxt.pm * tstep : cA; const char* nB = has_next ? (const char*)g.Bt + (size_t)nxt.pn * tstep : cB;
        for (int t = 0; t < nt; t += 2) {
            const bool last = (t == nt - 2);
            const char* a1 = cA + (size_t)(t + 1) * kstep;
            const char* a2 = last ? nA : cA + (size_t)(t + 2) * kstep; const char* b2 = last ? nB : cB + (size_t)(t + 2) * kstep;
            const char* a3 = a2 + kstep; const char* b3 = b2 + kstep;
            if (last && has_next) S.a_ready(nxt);
            PG8_LDB(B0, 0, 0); PG8_SCHED; PG8_LDA(At, 0, 0); PG8_STAGE(PG8_SA(1, 1), a1 + hstep, voffA);
            PG8_WAIT_L(8); PG8_BAR; PG8_WAIT_L(0); PG8_MMA(0, 0, At, B0); PG8_BAR; PG8_SCHED;
            PG8_LDB(B1, 0, 1); PG8_STAGE(PG8_SB(0, 0), b2, voffB);
            PG8_BAR; PG8_WAIT_L(0); PG8_MMA(0, 1, At, B1); PG8_BAR;
            PG8_LDA(At, 0, 1); PG8_STAGE(PG8_SA(0, 0), a2, voffA);
            PG8_BAR; PG8_WAIT_L(0); PG8_MMA(1, 0, At, B0); PG8_BAR; PG8_SCHED;
            PG8_STAGE(PG8_SB(0, 1), b2 + hstep, voffB);
            PG8_WAIT_V(6); PG8_BAR; PG8_MMA(1, 1, At, B1); PG8_BAR;
            PG8_LDB(B0, 1, 0); PG8_SCHED; PG8_LDA(At, 1, 0); PG8_STAGE(PG8_SA(0, 1), a2 + hstep, voffA);
            PG8_WAIT_L(8); PG8_BAR; PG8_WAIT_L(0); PG8_MMA(0, 0, At, B0); PG8_BAR; PG8_SCHED;
            PG8_LDB(B1, 1, 1); PG8_STAGE(PG8_SB(1, 0), b3, voffB);
            PG8_BAR; PG8_WAIT_L(0); PG8_MMA(0, 1, At, B1); PG8_BAR;
            PG8_LDA(At, 1, 1); PG8_STAGE(PG8_SA(1, 0), a3, voffA);
            PG8_BAR; PG8_WAIT_L(0); PG8_MMA(1, 0, At, B0); PG8_BAR; PG8_SCHED;
            PG8_STAGE(PG8_SB(1, 1), b3 + hstep, voffB);
            PG8_WAIT_V(6); PG8_BAR; PG8_MMA(1, 1, At, B1); PG8_BAR;
        }
        PG8_STAMP();
        if constexpr (!Epi::AFTER_DRAIN) { E(acc, cur, wr, wc, fr, fq); S.done(cur); }
        PG8_STAMP();
        if (!has_next) break;
#pragma unroll
        for (int a = 0; a < 2; ++a)
#pragma unroll
            for (int b = 0; b < 2; ++b)
#pragma unroll
                for (int m = 0; m < 4; ++m)
#pragma unroll
                    for (int n = 0; n < 2; ++n) acc[a][b][m][n] = (f32x4){0.f, 0.f, 0.f, 0.f};
        cur = nxt; cA = nA; cB = nB; ++ui;
    }
    PG8_WAIT_V(0);
    if (wr == 0) PG8_BAR;
    PG8_BAR;
    if constexpr (Epi::AFTER_DRAIN) { E.fused(acc, cur, wr, wc, fr, fq, lds, wid, lane); S.done(cur); }
    PG8_STAMP();
    if (STAMP && wid == 0) { stamps[lane] = lane < nts ? (((unsigned long long)(unsigned)ts_hi << 32) | (unsigned)ts_lo) : 0ull;
        if (lane == 62) stamps[62] = rt_entry; if (lane == 63) stamps[63] = (unsigned long long)wall_clock64(); }
#undef PG8_STAMP
#undef PG8_SA
#undef PG8_SB
#undef PG8_STAGE
#undef PG8_LDA
#undef PG8_LDB
#undef PG8_MMA
#undef PG8_WAIT_V
#undef PG8_WAIT_L
#undef PG8_BAR
#undef PG8_SCHED
}
}
using namespace pg8;
typedef float f32x16 __attribute__((ext_vector_type(16)));
typedef short s16x4 __attribute__((ext_vector_type(4)));
typedef unsigned u32x2 __attribute__((ext_vector_type(2)));

__device__ __forceinline__ float bf2f(bf16_t x) { return __uint_as_float(((unsigned)x) << 16); }
__device__ __forceinline__ bf16_t f2bf(float f) { unsigned u = __float_as_uint(f); u += 0x7FFFu + ((u >> 16) & 1u); return (bf16_t)(u >> 16); }
template <int CTRL> __device__ __forceinline__ float dpp_f(float v) { return __int_as_float(__builtin_amdgcn_update_dpp(0, __float_as_int(v), CTRL, 0xF, 0xF, true)); }
__device__ __forceinline__ float row16_sum(float v) {
    v += dpp_f<0xB1>(v);
    v += dpp_f<0x4E>(v);
    v += dpp_f<0x141>(v);
    v += dpp_f<0x140>(v);
    return v;
}
__device__ __forceinline__ float wave_sum(float v) { v = row16_sum(v); v += __shfl_xor(v, 16); v += __shfl_xor(v, 32); return v; }
__device__ __forceinline__ float fexp(float x) { return __builtin_amdgcn_exp2f(x * 1.4426950408889634f); }
__device__ __forceinline__ float flog(float x) { return __builtin_amdgcn_logf(x) * 0.6931471805599453f; }
__device__ __forceinline__ float siluf(float a) { return a * __builtin_amdgcn_rcpf(1.f + __expf(-a)); }

struct EpiU {
    static constexpr bool PERM = true, AFTER_DRAIN = false;
    bf16_t* O; int ldc;
    __device__ __forceinline__ void operator()(const f32x4 (&acc)[2][2][4][2], const Unit& u, int wr, int wc, int fr, int fq) const {
        const int row0 = u.pm * BM + wr * 64 + fr, col0 = u.pn * BM + wc * 32 + 8 * fq;
#pragma unroll
        for (int ai = 0; ai < 2; ++ai)
#pragma unroll
            for (int m = 0; m < 4; ++m) { bf16_t* rowp = O + (size_t)(row0 + ai * HALF + m * 16) * ldc + col0;
#pragma unroll
                for (int bj = 0; bj < 2; ++bj) { const f32x4 v0 = acc[ai][bj][m][0], v1 = acc[ai][bj][m][1];
                    u32x4 w = {cvt_pk_bf16(v0[0], v0[1]), cvt_pk_bf16(v0[2], v0[3]), cvt_pk_bf16(v1[0], v1[1]), cvt_pk_bf16(v1[2], v1[3])};
                    *(u32x4*)(rowp + bj * HALF) = w; } }
    }
};
struct EpiRes {
    static constexpr bool PERM = false, AFTER_DRAIN = false;
    float* Y; const float* xp; const float* xs; const float* mod;
    __device__ __forceinline__ void operator()(const f32x4 (&acc)[2][2][4][2], const Unit& u, int wr, int wc, int fr, int fq) const {
        const int row0 = u.pm * BM + wr * 64 + fr, col0 = u.pn * BM + wc * 32 + 4 * fq;
        const bool prompt = u.pm < 16; const int j = prompt ? 0 : 1 + ((u.pm - 16) >> 3);
        const float* gp = mod + j * 6144 + 4096 + col0;
        f32x4 gv[2][2];
#pragma unroll
        for (int bj = 0; bj < 2; ++bj)
#pragma unroll
            for (int n = 0; n < 2; ++n) gv[bj][n] = *(const f32x4*)(gp + bj * HALF + n * 16);
#pragma unroll
        for (int ai = 0; ai < 2; ++ai) {
            f32x4 xb[4][2][2];
#pragma unroll
            for (int m = 0; m < 4; ++m) { const int r = row0 + ai * HALF + m * 16;
                const float* bp = (prompt ? xp + (size_t)r * 2048 : xs + (size_t)(r - NPTOK) * 2048) + col0;
#pragma unroll
                for (int bj = 0; bj < 2; ++bj)
#pragma unroll
                    for (int n = 0; n < 2; ++n) xb[m][bj][n] = *(const f32x4*)(bp + bj * HALF + n * 16); }
#pragma unroll
            for (int m = 0; m < 4; ++m) { const int r = row0 + ai * HALF + m * 16; float* yp = Y + (size_t)r * 2048 + col0;
#pragma unroll
                for (int bj = 0; bj < 2; ++bj)
#pragma unroll
                    for (int n = 0; n < 2; ++n) *(f32x4*)(yp + bj * HALF + n * 16) = xb[m][bj][n] + gv[bj][n] * acc[ai][bj][m][n]; }
        }
    }
};

constexpr int QBLK = 32, KVBLK = 64;
constexpr float SCALE = 0.088388347648318440f;
constexpr float THR = 8.f;
constexpr size_t SHM_V = KVBLK * 128 * 2, SHM_K = KVBLK * 128 * 2;
constexpr int Q_LDS_OFF = 2 * 16384 + 2 * 16384 + 8 * 64 * 4;
#define KSWZ(row, colB) ((row) * 256 + ((colB) ^ (((row) & 7) << 4)))
#define SBAR() __builtin_amdgcn_sched_barrier(0)
__device__ __forceinline__ int crow(int r, int hi) { return (r & 3) + 8 * (r >> 2) + 4 * hi; }

__device__ __forceinline__ void partialSM(f32x16& p0, f32x16& p1, float& m_reg, float& mn, float& alpha, bool domask, int kd, int hi) {
  constexpr float C = SCALE * 1.4426950408889634f;
  if (domask) {
#pragma unroll
    for (int r = 0; r < 16; ++r) { const int kk = kd + crow(r, hi); p0[r] = (kk >= -128 && kk <= 128) ? p0[r] : -1e30f; p1[r] = (kk + 32 >= -128 && kk + 32 <= 128) ? p1[r] : -1e30f; }
  }
  float pmax = p0[0];
#pragma unroll
  for (int r = 1; r < 16; ++r) pmax = fmaxf(pmax, p0[r]);
#pragma unroll
  for (int r = 0; r < 16; ++r) pmax = fmaxf(pmax, p1[r]);
  { auto rr = __builtin_amdgcn_permlane32_swap(__float_as_uint(pmax), __float_as_uint(pmax), false, false);
    pmax = fmaxf(__uint_as_float(rr[0]), __uint_as_float(rr[1])); }
  if (__builtin_expect(__all(pmax - m_reg <= THR / SCALE), 1)) { mn = m_reg; alpha = 1.f; }
  else { mn = fmaxf(m_reg, pmax); alpha = __builtin_amdgcn_exp2f((m_reg - mn) * C); m_reg = mn; }
  float mnC = -mn * C;
#pragma unroll
  for (int r = 0; r < 16; ++r) p0[r] = fmaf(p0[r], C, mnC);
#pragma unroll
  for (int r = 0; r < 16; ++r) p1[r] = fmaf(p1[r], C, mnC);
#pragma unroll
  for (int r = 0; r < 16; ++r) p0[r] = __builtin_amdgcn_exp2f(p0[r]);
}
__device__ __forceinline__ void finishSM(f32x16& p0, f32x16& p1, float alpha, float& l_reg, bf16x8& pa0, bf16x8& pa1, bf16x8& pa2, bf16x8& pa3) {
#pragma unroll
  for (int r = 0; r < 16; ++r) p1[r] = __builtin_amdgcn_exp2f(p1[r]);
  float ps = 0;
#pragma unroll
  for (int r = 0; r < 16; ++r) ps += p0[r];
#pragma unroll
  for (int r = 0; r < 16; ++r) ps += p1[r];
  { auto rr = __builtin_amdgcn_permlane32_swap(__float_as_uint(ps), __float_as_uint(ps), false, false);
    ps = __uint_as_float(rr[0]) + __uint_as_float(rr[1]); }
  l_reg = l_reg * alpha + ps;
#define PK4(P, BASE, OUT) do { unsigned a0 = cvt_pk_bf16(P[BASE + 0], P[BASE + 1]), a1 = cvt_pk_bf16(P[BASE + 2], P[BASE + 3]);   \
    unsigned b0 = cvt_pk_bf16(P[BASE + 4], P[BASE + 5]), b1 = cvt_pk_bf16(P[BASE + 6], P[BASE + 7]);                              \
    auto r0 = __builtin_amdgcn_permlane32_swap(a0, b0, false, false); auto r1 = __builtin_amdgcn_permlane32_swap(a1, b1, false, false); \
    u32x4 w = {r0[0], r1[0], r0[1], r1[1]}; OUT = *reinterpret_cast<bf16x8*>(&w); } while (0)
  PK4(p0, 0, pa0); PK4(p0, 8, pa1); PK4(p1, 0, pa2); PK4(p1, 8, pa3);
#undef PK4
}
__device__ __forceinline__ void qkt(f32x16& p0, f32x16& p1, const bf16_t* Ks, const bf16x8* qr, int r32, int hi) {
  p0 = f32x16{}; p1 = f32x16{};
#pragma unroll
  for (int d0 = 0; d0 < 8; ++d0) { int cb = (d0 * 16 + hi * 8) * 2; const bf16x8 qf = qr[d0];
    bf16x8 b0 = *reinterpret_cast<const bf16x8*>((const char*)Ks + KSWZ(r32, cb));
    bf16x8 b1 = *reinterpret_cast<const bf16x8*>((const char*)Ks + KSWZ(32 + r32, cb));
    p0 = __builtin_amdgcn_mfma_f32_32x32x16_bf16(b0, qf, p0, 0, 0, 0);
    p1 = __builtin_amdgcn_mfma_f32_32x32x16_bf16(b1, qf, p1, 0, 0, 0); }
}
__device__ __forceinline__ int v_st(int k, int c) { const int kk = (k & ~0xC) | ((k & 4) << 1) | ((k & 8) >> 1); return ((kk >> 3) * 4 + (c >> 5)) * 512 + ((kk & 7) * 32 + (c & 31)) * 2; }
__device__ __forceinline__ int v_rd_base(int lane) { return ((lane & 3) << 3) | (((lane >> 2) & 3) << 6) | (((lane >> 4) & 1) << 5) | (((lane >> 5) & 1) << 8); }
constexpr int v_rd_off(int d0, int ks, int half) { return d0 * 512 + ks * 4096 + half * 2048; }
template <int OFF> __device__ __forceinline__ s16x4 tr_read(int vb) {
  s16x4 r; asm volatile("ds_read_b64_tr_b16 %0, %1 offset:%2" : "=&v"(r) : "v"(vb), "i"(OFF) : "memory"); return r;
}
template <int D0> __device__ __forceinline__ void pv_one(f32x16& od, int vb, bf16x8 pa0, bf16x8 pa1, bf16x8 pa2, bf16x8 pa3) {
  const s16x4 l0 = tr_read<v_rd_off(D0, 0, 0)>(vb), h0 = tr_read<v_rd_off(D0, 0, 1)>(vb), l1 = tr_read<v_rd_off(D0, 1, 0)>(vb), h1 = tr_read<v_rd_off(D0, 1, 1)>(vb);
  const s16x4 l2 = tr_read<v_rd_off(D0, 2, 0)>(vb), h2 = tr_read<v_rd_off(D0, 2, 1)>(vb), l3 = tr_read<v_rd_off(D0, 3, 0)>(vb), h3 = tr_read<v_rd_off(D0, 3, 1)>(vb);
  asm volatile("s_waitcnt lgkmcnt(0)" ::: "memory"); SBAR();
#define PK(L, H) (bf16x8){L[0], L[1], L[2], L[3], H[0], H[1], H[2], H[3]}
  od = __builtin_amdgcn_mfma_f32_32x32x16_bf16(pa0, PK(l0, h0), od, 0, 0, 0);
  od = __builtin_amdgcn_mfma_f32_32x32x16_bf16(pa1, PK(l1, h1), od, 0, 0, 0);
  od = __builtin_amdgcn_mfma_f32_32x32x16_bf16(pa2, PK(l2, h2), od, 0, 0, 0);
  od = __builtin_amdgcn_mfma_f32_32x32x16_bf16(pa3, PK(l3, h3), od, 0, 0, 0);
#undef PK
}
__device__ __forceinline__ void pv_d0(f32x16* o, int vb, bf16x8 pa0, bf16x8 pa1, bf16x8 pa2, bf16x8 pa3) {
  pv_one<0>(o[0], vb, pa0, pa1, pa2, pa3); pv_one<1>(o[1], vb, pa0, pa1, pa2, pa3); pv_one<2>(o[2], vb, pa0, pa1, pa2, pa3); pv_one<3>(o[3], vb, pa0, pa1, pa2, pa3);
}

template <int LDQ>
__device__ __forceinline__ void attn_body(const bf16_t* __restrict__ Qb, const bf16_t* __restrict__ Kh, const bf16_t* __restrict__ Vh,
                                          const bf16_t* __restrict__ Gb, bf16_t* __restrict__ Ob, const int NT, const int nctx, const int ctx_base,
                                          const int lat_start, const bool window, const int i0, const float* __restrict__ sinkp, char* lds, const bool pack4 = false) {
  constexpr int LDK = 128;
  int tid_ = threadIdx.x; asm volatile("" : "+v"(tid_));
  const int tid = tid_, wid = __builtin_amdgcn_readfirstlane(tid >> 6), lane = tid & 63, r32 = lane & 31, hi = lane >> 5;
  bf16_t* V_lds = (bf16_t*)lds; bf16_t* K_lds = (bf16_t*)(lds + 2 * SHM_V);
  float* ws = (float*)(lds + 2 * SHM_V + 2 * SHM_K) + wid * 64; float* li_l = ws; float* al_l = ws + 32;
  float m_reg = -1e30f, l_reg = 0; f32x16 o[4] = {};
  const int wrow = pack4 ? (wid & 1) * 32 : wid * 32, whead = pack4 ? (wid >> 1) * 128 : 0;
  bf16x8 qr[8];
  { const bf16_t* Qw = Qb + (long)(wrow + r32) * LDQ + whead + hi * 8;
#pragma unroll
    for (int d0 = 0; d0 < 8; ++d0) qr[d0] = *reinterpret_cast<const bf16x8*>(Qw + d0 * 16); }
  const int sr = tid >> 4, sc = (tid & 15) * 8, vst0 = v_st(sr, sc), vst1 = v_st(32 + sr, sc);
  const int vb0 = (int)(uintptr_t)V_lds + v_rd_base(lane);
  const int qpos = i0 + wrow + r32, qw = i0 + wrow;
  struct { bf16x8 vs0, vs1, ks0, ks1; } sr_[2];
#define KOFF(j) ((j) < nctx ? ctx_base + (j) * 64 : (lat_start + (j) - nctx) * 64)
#define DOMASK(j, k0) (window && (j) >= nctx && !(((k0) + 63 - qw <= 128) && (qw + 31 - (k0) <= 128)))
#define SLOAD(i, k0) do { sr_[i].vs0 = *(const bf16x8*)(&Vh[(long)((k0) + sr) * LDK + sc]); sr_[i].vs1 = *(const bf16x8*)(&Vh[(long)((k0) + 32 + sr) * LDK + sc]); \
    sr_[i].ks0 = *(const bf16x8*)(&Kh[(long)((k0) + sr) * LDK + sc]); sr_[i].ks1 = *(const bf16x8*)(&Kh[(long)((k0) + 32 + sr) * LDK + sc]); } while (0)
#define SWRITE(b, i) do { *(bf16x8*)((char*)V_lds + (b) * SHM_V + vst0) = sr_[i].vs0;          \
    *(bf16x8*)((char*)V_lds + (b) * SHM_V + vst1) = sr_[i].vs1; int kc = sc * 2;               \
    *(bf16x8*)((char*)K_lds + (b) * SHM_K + KSWZ(sr, kc)) = sr_[i].ks0;                       \
    *(bf16x8*)((char*)K_lds + (b) * SHM_K + KSWZ(32 + sr, kc)) = sr_[i].ks1; } while (0)
#define SWAIT() asm volatile("s_waitcnt vmcnt(4)" ::: "memory")
#define RESC(a) do { if (__any((a) < 1.f)) { if (hi == 0) al_l[r32] = (a); asm volatile("s_waitcnt lgkmcnt(0)" ::: "memory"); \
    _Pragma("unroll") for (int d = 0; d < 4; ++d) _Pragma("unroll") for (int r = 0; r < 16; ++r) o[d][r] *= al_l[crow(r, hi)]; } } while (0)
  f32x16 pA0, pA1, pB0, pB1; float mnA, mnB, alA, alB; bf16x8 pa0, pa1, pa2, pa3;
  constexpr int SE = 0, SO = 1;
  int kcur = KOFF(0);
  SLOAD(SE, kcur); asm volatile("s_waitcnt vmcnt(0)" ::: "memory"); SWRITE(0, SE); __syncthreads();
  qkt(pA0, pA1, K_lds, qr, r32, hi); partialSM(pA0, pA1, m_reg, mnA, alA, DOMASK(0, kcur), kcur - qpos, hi);
  { const int k1 = KOFF(1); SLOAD(SO, k1); } if (2 < NT) { const int k2 = KOFF(2); SLOAD(SE, k2); }
  SWAIT(); SWRITE(1, SO); __syncthreads();
  for (int j = 1; j + 1 < NT; j += 2) {
    SBAR(); qkt(pB0, pB1, (bf16_t*)((char*)K_lds + SHM_K), qr, r32, hi);
    finishSM(pA0, pA1, alA, l_reg, pa0, pa1, pa2, pa3); SBAR();
    if (j + 2 < NT) { const int kn = KOFF(j + 2); SLOAD(SO, kn); } SBAR();
    { const int kj = KOFF(j); pv_d0(o, vb0, pa0, pa1, pa2, pa3); partialSM(pB0, pB1, m_reg, mnB, alB, DOMASK(j, kj), kj - qpos, hi); }
    __syncthreads(); SWAIT(); SWRITE(0, SE);
    RESC(alB); __syncthreads();
    SBAR(); qkt(pA0, pA1, K_lds, qr, r32, hi);
    finishSM(pB0, pB1, alB, l_reg, pa0, pa1, pa2, pa3); SBAR();
    if (j + 3 < NT) { const int kn = KOFF(j + 3); SLOAD(SE, kn); } SBAR();
    { const int kj = KOFF(j + 1); pv_d0(o, vb0 + (int)SHM_V, pa0, pa1, pa2, pa3); partialSM(pA0, pA1, m_reg, mnA, alA, DOMASK(j + 1, kj), kj - qpos, hi); }
    __syncthreads(); SWAIT(); SWRITE(1, SO);
    RESC(alA); __syncthreads();
  }
  if (NT & 1) {
    finishSM(pA0, pA1, alA, l_reg, pa0, pa1, pa2, pa3); SBAR();
    pv_d0(o, vb0, pa0, pa1, pa2, pa3);
  } else {
    SBAR(); qkt(pB0, pB1, (bf16_t*)((char*)K_lds + SHM_K), qr, r32, hi);
    finishSM(pA0, pA1, alA, l_reg, pa0, pa1, pa2, pa3); SBAR();
    { const int kj = KOFF(NT - 1); pv_d0(o, vb0, pa0, pa1, pa2, pa3); partialSM(pB0, pB1, m_reg, mnB, alB, DOMASK(NT - 1, kj), kj - qpos, hi); }
    __syncthreads(); RESC(alB);
    finishSM(pB0, pB1, alB, l_reg, pa0, pa1, pa2, pa3); SBAR();
    pv_d0(o, vb0 + (int)SHM_V, pa0, pa1, pa2, pa3);
  }
  if (sinkp) l_reg += __builtin_amdgcn_exp2f(sinkp[pack4 ? (wid >> 1) : 0] * 1.4426950408889634f - m_reg * (SCALE * 1.4426950408889634f));
  if (hi == 0) li_l[r32] = l_reg; asm volatile("s_waitcnt lgkmcnt(0)" ::: "memory");
  const bf16_t* Gw = Gb + (long)wrow * LDQ + whead; bf16_t* Ow = Ob + (long)wrow * 2048 + whead;
  char* ot = lds + O_LDS_OFF + wid * 8704;
  bf16x8 gvr[8];
#pragma unroll
  for (int it = 0; it < 8; ++it) gvr[it] = *(const bf16x8*)(Gw + (long)(it * 4 + (lane >> 4)) * LDQ + (lane & 15) * 8);
#pragma unroll
  for (int r = 0; r < 16; ++r) { const int orow = crow(r, hi); const float rl = __builtin_amdgcn_rcpf(li_l[orow]);
    const unsigned p01 = cvt_pk_bf16(o[0][r] * rl, o[1][r] * rl), p23 = cvt_pk_bf16(o[2][r] * rl, o[3][r] * rl);
    char* op = ot + orow * 272 + r32 * 2;
    *(bf16_t*)(op) = (bf16_t)(p01 & 0xffffu); *(bf16_t*)(op + 64) = (bf16_t)(p01 >> 16);
    *(bf16_t*)(op + 128) = (bf16_t)(p23 & 0xffffu); *(bf16_t*)(op + 192) = (bf16_t)(p23 >> 16); }
  asm volatile("s_waitcnt lgkmcnt(0)" ::: "memory");
#pragma unroll
  for (int it = 0; it < 8; ++it) { const int row = it * 4 + (lane >> 4), c8 = (lane & 15) * 8;
    const bf16x8 ov = *(const bf16x8*)(ot + row * 272 + c8 * 2); const bf16x8 gv = gvr[it];
    float f[8];
#pragma unroll
    for (int j = 0; j < 8; ++j) f[j] = bf2f((bf16_t)ov[j]) * siluf(bf2f((bf16_t)gv[j]));
    const u32x4 w = {cvt_pk_bf16(f[0], f[1]), cvt_pk_bf16(f[2], f[3]), cvt_pk_bf16(f[4], f[5]), cvt_pk_bf16(f[6], f[7])};
    *(u32x4*)(Ow + (long)row * 2048 + c8) = w; }
#undef SLOAD
#undef SWRITE
#undef SWAIT
#undef RESC
#undef KOFF
#undef DOMASK
}

#define MFMA16(a, b, c) __builtin_amdgcn_mfma_f32_16x16x32_bf16((a), (b), (c), 0, 0, 0)
__device__ __forceinline__ bf16x8 as_bf8(u32x4 w) { return *reinterpret_cast<bf16x8*>(&w); }
__device__ __forceinline__ void hgrn_chain(const Params& p, char* lds, int item) {
    int tid_ = threadIdx.x; asm volatile("" : "+v"(tid_));
    const int tid = tid_, wid = __builtin_amdgcn_readfirstlane(tid >> 6), lane = tid & 63, l16 = lane & 15, g = lane >> 4;
    const bool samp = item < 128; const int it = samp ? item : item - 128;
    const int b = it >> 4, h = (it >> 1) & 7, dir = it & 1;
    const int L = samp ? 2048 : 256; const long tok0 = samp ? NPTOK + (long)b * 2048 : (long)b * 256;
    const int nchunk = L >> 5;
    char* ws = p.ws; asm volatile("" : "+s"(ws));
    bf16_t* U = (bf16_t*)(ws + WS_U);
    const int d = l16 + 16 * wid, part = g;
    const int lt = tid >> 4, ld8 = (tid & 15) * 8;
    const float lbv = ((const float*)(ws + WS_LB))[dir * 1024 + h * 128 + d];
    constexpr int TILE_B = 38400;
    bf16_t* otile0 = (bf16_t*)(lds + 2 * TILE_B);
    bf16_t* raw = otile0 + 2 * 32 * 136;
    f32x4 S[8];
    if (samp) { const float* st = p.in[2] + (size_t)((b * 2 + dir) * 8 + h) * 16384;
#pragma unroll
        for (int m = 0; m < 8; ++m)
#pragma unroll
            for (int i = 0; i < 4; ++i) S[m][i] = st[(16 * m + 4 * g + i) * 128 + 16 * wid + l16];
    } else {
#pragma unroll
        for (int m = 0; m < 8; ++m) S[m] = (f32x4){0.f, 0.f, 0.f, 0.f};
    }
    const int gcol = 1024 * (1 + dir);
    bf16_t* ubase = U + h * 128 + ld8;
    bf16x8 rq, rf, ri;
#define HTOK(c) ((size_t)(tok0 + (dir ? (L - 1 - ((c) * 32 + lt)) : ((c) * 32 + lt))) * LDU0)
#define HLD(c) do { const bf16_t* u_ = ubase + HTOK(c); rq = *(const bf16x8*)(u_); rf = *(const bf16x8*)(u_ + gcol); ri = *(const bf16x8*)(u_ + 3072); } while (0)
#define HWR(c) do { bf16_t* r_ = raw + ((c) & 1) * (3 * 32 * 136) + lt * 136 + ld8; *(bf16x8*)(r_) = rq; *(bf16x8*)(r_ + 32 * 136) = rf; *(bf16x8*)(r_ + 2 * 32 * 136) = ri; } while (0)
#define HOST(c) do { *(bf16x8*)(U + HTOK(c) + gcol + h * 128 + ld8) = *(const bf16x8*)(otile0 + ((c) & 1) * (32 * 136) + lt * 136 + ld8); } while (0)
    HLD(0); HWR(0);
    if (nchunk > 1) HLD(1);
    __syncthreads();
    for (int c = 0; c < nchunk; ++c) {
        char* tb = lds + (c & 1) * TILE_B;
        bf16_t* qd = (bf16_t*)tb; bf16_t* ki = qd + 32 * 136; bf16_t* keT = ki + 32 * 136; bf16_t* vT = keT + 128 * 40; float* dec = (float*)(vT + 128 * 40);
        const bf16_t* rw = raw + (c & 1) * (3 * 32 * 136) + (part * 8) * 136 + d;
        float q[8], k[8], bl[8]; unsigned vv[4]; bf16_t rq_[8], rf_[8], ri_[8];
        float cum = 0.f;
#pragma unroll
        for (int tt = 0; tt < 8; ++tt) { rq_[tt] = rw[tt * 136]; rf_[tt] = rw[32 * 136 + tt * 136]; ri_[tt] = rw[2 * 32 * 136 + tt * 136]; }
        asm volatile("s_waitcnt lgkmcnt(0)" ::: "memory"); __builtin_amdgcn_sched_barrier(0);
#pragma unroll
        for (int tt = 0; tt < 8; ++tt) { q[tt] = siluf(bf2f(rq_[tt])); const float sg = __builtin_amdgcn_rcpf(1.f + fexp(-bf2f(rf_[tt])));
            const float f = lbv + (1.f - lbv) * sg; k[tt] = 1.f - f; cum += flog(f); bl[tt] = cum; }
#pragma unroll
        for (int tt = 0; tt < 4; ++tt) vv[tt] = (unsigned)ri_[2 * tt] | ((unsigned)ri_[2 * tt + 1] << 16);
        const float c1 = __shfl_xor(cum, 16), c2 = __shfl_xor(cum, 32), c3 = __shfl_xor(cum, 48);
        const float blast = cum + c1 + c2 + c3;
        const float off = ((part & 1) ? c1 : 0.f) + ((part & 2) ? c2 + c3 : 0.f);
        float ke[8]; const float eblast = fexp(blast);
#pragma unroll
        for (int tt = 0; tt < 8; ++tt) { const float bb = off + bl[tt]; const int t = part * 8 + tt;
            const float kiv = k[tt] * fexp(-bb); qd[t * 136 + d] = f2bf(q[tt] * fexp(bb)); ki[t * 136 + d] = f2bf(kiv); ke[tt] = kiv * eblast; }
        { u32x4 w = {cvt_pk_bf16(ke[0], ke[1]), cvt_pk_bf16(ke[2], ke[3]), cvt_pk_bf16(ke[4], ke[5]), cvt_pk_bf16(ke[6], ke[7])};
          *(u32x4*)(keT + d * 40 + part * 8) = w; u32x4 w2 = {vv[0], vv[1], vv[2], vv[3]}; *(u32x4*)(vT + d * 40 + part * 8) = w2; }
        if (part == 0) dec[d] = eblast;
        if (c >= 2) HOST(c - 2);
        if (c + 1 < nchunk) { HWR(c + 1); if (c + 2 < nchunk) HLD(c + 2); }
        __syncthreads();
        f32x4 T00 = {0.f, 0.f, 0.f, 0.f}, T01 = T00, T11 = T00;
#pragma unroll
        for (int ks = 0; ks < 4; ++ks) {
            const bf16x8 a0 = *(const bf16x8*)(ki + l16 * 136 + 32 * ks + 8 * g), a1 = *(const bf16x8*)(ki + (16 + l16) * 136 + 32 * ks + 8 * g);
            const bf16x8 b0 = *(const bf16x8*)(qd + l16 * 136 + 32 * ks + 8 * g), b1 = *(const bf16x8*)(qd + (16 + l16) * 136 + 32 * ks + 8 * g);
            T00 = MFMA16(a0, b0, T00); T01 = MFMA16(a0, b1, T01); T11 = MFMA16(a1, b1, T11);
        }
#pragma unroll
        for (int i = 0; i < 4; ++i) if (4 * g + i > l16) { T00[i] = 0.f; T11[i] = 0.f; }
        const u32x4 P0w = {cvt_pk_bf16(T00[0], T00[1]), cvt_pk_bf16(T00[2], T00[3]), 0u, 0u};
        const u32x4 P1w = {cvt_pk_bf16(T01[0], T01[1]), cvt_pk_bf16(T01[2], T01[3]), cvt_pk_bf16(T11[0], T11[1]), cvt_pk_bf16(T11[2], T11[3])};
        const bf16_t* vrow = vT + (16 * wid + l16) * 40;
        const u32x2 vlo = *(const u32x2*)(vrow + 4 * g), vhi = *(const u32x2*)(vrow + 16 + 4 * g);
        const u32x4 Bvw = {vlo[0], vlo[1], vhi[0], vhi[1]};
        f32x4 o0 = {0.f, 0.f, 0.f, 0.f}, o1 = o0;
        o0 = MFMA16(as_bf8(P0w), as_bf8(Bvw), o0); o1 = MFMA16(as_bf8(P1w), as_bf8(Bvw), o1);
#pragma unroll
        for (int ks = 0; ks < 4; ++ks) {
            const u32x2 x0 = *(const u32x2*)(qd + l16 * 136 + 32 * ks + 4 * g), x1 = *(const u32x2*)(qd + l16 * 136 + 32 * ks + 16 + 4 * g);
            const u32x2 y0 = *(const u32x2*)(qd + (16 + l16) * 136 + 32 * ks + 4 * g), y1 = *(const u32x2*)(qd + (16 + l16) * 136 + 32 * ks + 16 + 4 * g);
            const u32x4 A0w = {x0[0], x0[1], x1[0], x1[1]}, A1w = {y0[0], y0[1], y1[0], y1[1]};
            const u32x4 Bsw = {cvt_pk_bf16(S[2 * ks][0], S[2 * ks][1]), cvt_pk_bf16(S[2 * ks][2], S[2 * ks][3]),
                               cvt_pk_bf16(S[2 * ks + 1][0], S[2 * ks + 1][1]), cvt_pk_bf16(S[2 * ks + 1][2], S[2 * ks + 1][3])};
            o0 = MFMA16(as_bf8(A0w), as_bf8(Bsw), o0); o1 = MFMA16(as_bf8(A1w), as_bf8(Bsw), o1);
        }
        const bf16x8 bvv = *(const bf16x8*)(vrow + 8 * g);
#pragma unroll
        for (int m = 0; m < 8; ++m) { const f32x4 dc = *(const f32x4*)(dec + 16 * m + 4 * g); S[m] = S[m] * dc;
            const bf16x8 a = *(const bf16x8*)(keT + (16 * m + l16) * 40 + 8 * g); S[m] = MFMA16(a, bvv, S[m]); }
        bf16_t* otile = otile0 + (c & 1) * (32 * 136);
#pragma unroll
        for (int i = 0; i < 4; ++i) { otile[(4 * g + i) * 136 + 16 * wid + l16] = f2bf(o0[i]); otile[(16 + 4 * g + i) * 136 + 16 * wid + l16] = f2bf(o1[i]); }
    }
    __syncthreads();
    if (nchunk >= 2) HOST(nchunk - 2);
    HOST(nchunk - 1);
    if (!samp) { float* st = p.out + OUT_STATE + (size_t)((b * 2 + dir) * 8 + h) * 16384;
#pragma unroll
        for (int m = 0; m < 8; ++m)
#pragma unroll
            for (int i = 0; i < 4; ++i) st[(16 * m + 4 * g + i) * 128 + 16 * wid + l16] = S[m][i];
    }
#undef HLD
#undef HWR
#undef HTOK
#undef HOST
}

__device__ __forceinline__ void mod_gemv(const Params& p, char* lds, const int layer, const int first, const int stride) {
    const int tid = threadIdx.x;
    float* sl = (float*)lds;
    float* red = (float*)(lds + 73728);
    __syncthreads();
    for (int idx = tid; idx < 9 * 2048; idx += 512) { const int j = idx >> 11, k = idx & 2047; const float c = j ? p.in[7][(j - 1) * 2048 + k] : p.in[8][k]; sl[idx] = siluf(c); }
    __syncthreads();
    for (int colg = first; colg < 96; colg += stride) {
        const int lane = tid & 63, cq = lane & 15, kp = (tid >> 6) * 4 + (lane >> 4);
        const float* W = p.in[layer ? 19 : 11] + (size_t)(kp * 64) * 6144 + colg * 64 + cq * 4; const float* bm = p.in[layer ? 20 : 12];
        f32x4 acc[9];
#pragma unroll
        for (int j = 0; j < 9; ++j) acc[j] = (f32x4){0.f, 0.f, 0.f, 0.f};
        for (int k0 = 0; k0 < 64; k0 += 8) {
            f32x4 w[8];
#pragma unroll
            for (int u = 0; u < 8; ++u) w[u] = *(const f32x4*)(W + (size_t)(k0 + u) * 6144);
#pragma unroll
            for (int j = 0; j < 9; ++j) { const f32x4 s0 = *(const f32x4*)(sl + j * 2048 + kp * 64 + k0), s1 = *(const f32x4*)(sl + j * 2048 + kp * 64 + k0 + 4);
                acc[j] += w[0] * s0[0] + w[1] * s0[1] + w[2] * s0[2] + w[3] * s0[3] + w[4] * s1[0] + w[5] * s1[1] + w[6] * s1[2] + w[7] * s1[3]; }
        }
#pragma unroll
        for (int j = 0; j < 9; ++j)
#pragma unroll
            for (int e = 0; e < 4; ++e) { float v = acc[j][e]; v += __shfl_xor(v, 16); v += __shfl_xor(v, 32); acc[j][e] = v; }
        if (lane < 16) {
#pragma unroll
            for (int j = 0; j < 9; ++j) *(f32x4*)(red + ((tid >> 6) * 9 + j) * 64 + cq * 4) = acc[j]; }
        __syncthreads();
        for (int idx = tid; idx < 576; idx += 512) { const int j = idx >> 6, c2 = idx & 63; float s_ = 0.f;
#pragma unroll
            for (int q = 0; q < 8; ++q) s_ += red[(q * 9 + j) * 64 + c2];
            ((float*)(p.ws + WS_MOD))[(layer * 9 + j) * 6144 + colg * 64 + c2] = s_ + bm[colg * 64 + c2]; }
        __syncthreads();
    }
}
__device__ __forceinline__ void wt_tasks(const Params& p, char* lds, const int t0, const int cnt) {
    const int tid = threadIdx.x;
    bf16_t* T = (bf16_t*)lds;
    __syncthreads();
    for (int t = t0; t < t0 + cnt; ++t) {
        const int ct = t >> 4, kt = t & 15; const float* W; bf16_t* WT; int N, nt;
        if (ct < 120) { W = p.in[13]; WT = (bf16_t*)(p.ws + WS_WT_IN0); N = 7680; nt = ct; }
        else if (ct < 152) { W = p.in[14]; WT = (bf16_t*)(p.ws + WS_WT_OUT0); N = 2048; nt = ct - 120; }
        else if (ct < 232) { W = p.in[21]; WT = (bf16_t*)(p.ws + WS_WT_IN1); N = 5120; nt = ct - 152; }
        else { W = p.in[22]; WT = (bf16_t*)(p.ws + WS_WT_OUT1); N = 2048; nt = ct - 232; }
        const int r = tid >> 4, c4 = (tid & 15) * 4;
#pragma unroll
        for (int itr = 0; itr < 4; ++itr) { const int kk = itr * 32 + r; const f32x4 v = *(const f32x4*)(W + (size_t)(kt * 128 + kk) * N + nt * 64 + c4);
#pragma unroll
            for (int e = 0; e < 4; ++e) T[(c4 + e) * 136 + kk] = f2bf(v[e]); }
        __syncthreads();
        { const int n = tid >> 3, k16 = (tid & 7) * 16; bf16_t* dst = WT + (size_t)(nt * 64 + n) * 2048 + kt * 128 + k16;
          *(u32x4*)dst = *(const u32x4*)(T + n * 136 + k16); *(u32x4*)(dst + 8) = *(const u32x4*)(T + n * 136 + k16 + 8); }
        __syncthreads();
    }
}
__device__ __forceinline__ void phase_prologue(const Params& p, char* lds) {
    const int tid = threadIdx.x, c = (int)blockIdx.x;
    if (c < 96) mod_gemv(p, lds, 0, c, 96);
    if (c == (int)gridDim.x - 1) {
        for (int idx = tid; idx < 2048; idx += 512) { const float g0 = p.in[9][idx], g1 = p.in[9][2048 + idx], g2 = p.in[9][4096 + idx];
            const float m = fmaxf(g0, fmaxf(g1, g2)); const float e0 = __expf(g0 - m), e1 = __expf(g1 - m), e2 = __expf(g2 - m);
            ((float*)(p.ws + WS_LB))[idx] = e0 / (e0 + e1 + e2); }
    }
    if (c < 96) wt_tasks(p, lds, c * 5, 5); else wt_tasks(p, lds, 480 + (c - 96) * 9, 9);
}
__device__ __forceinline__ void tail_fill_p2(const Params& p, char* lds) {
    const int idx = (int)blockIdx.x - 96; if (idx < 0) return;
    if (idx < 96) { mod_gemv(p, lds, 1, idx, 96); wt_tasks(p, lds, 1920 + idx * 10, 10); }
    else wt_tasks(p, lds, 1920 + 960 + (idx - 96) * 13, 13);
}
__device__ __forceinline__ void tail_fill_p6(const Params& p, char* lds) {
    const int idx = (int)blockIdx.x - 128; if (idx < 0) return;
    wt_tasks(p, lds, 3712 + idx * 4, 4);
}

__device__ __forceinline__ void phase_norm(const float* xa, const float* xb, const float* g, const float* mod, bf16_t* H) {
    const int lane = threadIdx.x & 63, gw = blockIdx.x * 8 + (threadIdx.x >> 6), nw = gridDim.x * 8;
#define NCOL(i) ((((i) >> 1) * 64 + lane) * 8 + ((i) & 1) * 4)
    for (int row = gw; row < NTOK; row += 2 * nw) {
        const int row2 = row + nw; const bool has2 = row2 < NTOK; const int r2 = has2 ? row2 : row;
        const float* src = row < NPTOK ? xa + (size_t)row * 2048 : xb + (size_t)(row - NPTOK) * 2048;
        const float* src2 = r2 < NPTOK ? xa + (size_t)r2 * 2048 : xb + (size_t)(r2 - NPTOK) * 2048;
        f32x4 v[8], v2[8]; float ss = 0.f, ss2 = 0.f;
#pragma unroll
        for (int i = 0; i < 8; ++i) v[i] = *(const f32x4*)(src + NCOL(i));
#pragma unroll
        for (int i = 0; i < 8; ++i) v2[i] = *(const f32x4*)(src2 + NCOL(i));
#pragma unroll
        for (int i = 0; i < 8; ++i) ss += v[i][0] * v[i][0] + v[i][1] * v[i][1] + v[i][2] * v[i][2] + v[i][3] * v[i][3];
#pragma unroll
        for (int i = 0; i < 8; ++i) ss2 += v2[i][0] * v2[i][0] + v2[i][1] * v2[i][1] + v2[i][2] * v2[i][2] + v2[i][3] * v2[i][3];
        ss = wave_sum(ss); ss2 = wave_sum(ss2);
        const float rstd = rsqrtf(ss * (1.f / 2048.f) + 1e-6f), rstd2 = rsqrtf(ss2 * (1.f / 2048.f) + 1e-6f);
        const int j = row < NPTOK ? 0 : 1 + ((row - NPTOK) >> 11), j2 = r2 < NPTOK ? 0 : 1 + ((r2 - NPTOK) >> 11);
        const float* sh = mod + j * 6144; const float* sc = sh + 2048; const float* sh2 = mod + j2 * 6144; const float* sc2 = sh2 + 2048;
#pragma unroll
        for (int ip = 0; ip < 4; ++ip) { const int col = (ip * 64 + lane) * 8;
            const f32x4 ga = *(const f32x4*)(g + col), gb = *(const f32x4*)(g + col + 4);
            { const f32x4 ya = v[2 * ip] * rstd * ga * (*(const f32x4*)(sc + col) + 1.f) + *(const f32x4*)(sh + col), yb = v[2 * ip + 1] * rstd * gb * (*(const f32x4*)(sc + col + 4) + 1.f) + *(const f32x4*)(sh + col + 4);
              const u32x4 w = {cvt_pk_bf16(ya[0], ya[1]), cvt_pk_bf16(ya[2], ya[3]), cvt_pk_bf16(yb[0], yb[1]), cvt_pk_bf16(yb[2], yb[3])}; *(u32x4*)(H + (size_t)row * 2048 + col) = w; }
            if (has2) { const f32x4 ya = v2[2 * ip] * rstd2 * ga * (*(const f32x4*)(sc2 + col) + 1.f) + *(const f32x4*)(sh2 + col), yb = v2[2 * ip + 1] * rstd2 * gb * (*(const f32x4*)(sc2 + col + 4) + 1.f) + *(const f32x4*)(sh2 + col + 4);
              const u32x4 w = {cvt_pk_bf16(ya[0], ya[1]), cvt_pk_bf16(ya[2], ya[3]), cvt_pk_bf16(yb[0], yb[1]), cvt_pk_bf16(yb[2], yb[3])}; *(u32x4*)(H + (size_t)row2 * 2048 + col) = w; } }
    }
#undef NCOL
}

template <int LAYER>
__device__ __forceinline__ void phase_prep(const Params& p) {
    constexpr int LDU = LAYER ? LDU1 : LDU0, QOFF = LAYER ? 0 : 5120, NQH = LAYER ? 16 : 8, KOFF_ = LAYER ? 2048 : 6144, NKH = LAYER ? 4 : 2;
    constexpr int NQS = NQH / 4, NKS = (2 * NKH) / 4;
    const float* qn = p.in[LAYER ? 23 : 16]; const float* kn = p.in[LAYER ? 24 : 17];
    float* outk = p.out + (LAYER ? OUT_L1K : OUT_L0K); float* outv = p.out + (LAYER ? OUT_L1V : OUT_L0V);
    const float* ck = p.in[LAYER ? 5 : 3]; const float* cv = p.in[LAYER ? 6 : 4];
    bf16_t* U = (bf16_t*)(p.ws + WS_U); bf16_t* KS = (bf16_t*)(p.ws + WS_KS); bf16_t* VS = (bf16_t*)(p.ws + WS_VS); bf16_t* KP = (bf16_t*)(p.ws + WS_KP); bf16_t* VP = (bf16_t*)(p.ws + WS_VP);
    const int lane = threadIdx.x & 63, gw = blockIdx.x * 8 + (threadIdx.x >> 6), nw = gridDim.x * 8;
    const int sub = lane >> 4, l16 = lane & 15, c8 = l16 * 8, a = (l16 >> 3) & 1, i0 = (l16 & 3) * 8;
    const float sgn = ((l16 >> 2) & 1) ? 1.f : -1.f;
    float qw[8], kw[8], inv[8];
#pragma unroll
    for (int j = 0; j < 8; ++j) { qw[j] = qn[c8 + j]; kw[j] = kn[c8 + j]; inv[j] = exp2f(-(float)(i0 + j) * (13.287712379549449f / 32.f)) * 0.15915494309189535f; }
    for (int tok = gw; tok < NTOK; tok += nw) {
        const bool samp = tok >= NPTOK; int b, t; if (samp) { b = (tok - NPTOK) >> 11; t = (tok - NPTOK) & 2047; } else { b = tok >> 8; t = tok & 255; }
        bf16_t* u = U + (size_t)tok * LDU + c8;
        bf16x8 xq[NQS], xkv[NKS];
#pragma unroll
        for (int s_ = 0; s_ < NQS; ++s_) xq[s_] = *(const bf16x8*)(u + QOFF + (s_ * 4 + sub) * 128);
#pragma unroll
        for (int s_ = 0; s_ < NKS; ++s_) xkv[s_] = *(const bf16x8*)(u + KOFF_ + (s_ * 4 + sub) * 128);
        float cs[8], sn[8];
#pragma unroll
        for (int j = 0; j < 8; ++j) { cs[j] = 1.f; sn[j] = 0.f; }
        if (samp) { const float pos = (float)(a ? (t & 63) : (t >> 6));
#pragma unroll
            for (int j = 0; j < 8; ++j) { float r = pos * inv[j]; r -= floorf(r); sn[j] = __builtin_amdgcn_sinf(r) * sgn; cs[j] = __builtin_amdgcn_cosf(r); } }
#pragma unroll
        for (int s_ = 0; s_ < NQS; ++s_) { float y[8], ss = 0.f;
#pragma unroll
            for (int j = 0; j < 8; ++j) { y[j] = bf2f((bf16_t)xq[s_][j]); ss += y[j] * y[j]; }
            ss = row16_sum(ss);
            const float rstd = rsqrtf(ss * (1.f / 128.f) + 1e-6f);
#pragma unroll
            for (int j = 0; j < 8; ++j) y[j] *= rstd * qw[j];
            float o[8];
#pragma unroll
            for (int j = 0; j < 8; ++j) o[j] = y[j] * cs[j] + __shfl_xor(y[j], 4) * sn[j];
            const u32x4 w = {cvt_pk_bf16(o[0], o[1]), cvt_pk_bf16(o[2], o[3]), cvt_pk_bf16(o[4], o[5]), cvt_pk_bf16(o[6], o[7])};
            *(u32x4*)(u + QOFF + (s_ * 4 + sub) * 128) = w; }
#pragma unroll
        for (int s_ = 0; s_ < NKS; ++s_) { const int slot = s_ * 4 + sub; const bool isk = slot < NKH; const int h = isk ? slot : slot - NKH;
            float x[8], y[8], ss = 0.f;
#pragma unroll
            for (int j = 0; j < 8; ++j) { x[j] = bf2f((bf16_t)xkv[s_][j]); ss += x[j] * x[j]; }
            ss = row16_sum(ss);
            const float rstd = rsqrtf(ss * (1.f / 128.f) + 1e-6f);
#pragma unroll
            for (int j = 0; j < 8; ++j) y[j] = x[j] * rstd * kw[j];
            float o[8];
#pragma unroll
            for (int j = 0; j < 8; ++j) { const float z = __shfl_xor(y[j], 4); o[j] = isk ? (y[j] * cs[j] + z * sn[j]) : x[j]; }
            const u32x4 w = {cvt_pk_bf16(o[0], o[1]), cvt_pk_bf16(o[2], o[3]), cvt_pk_bf16(o[4], o[5]), cvt_pk_bf16(o[6], o[7])};
            if (!samp) { float* of = (isk ? outk : outv) + ((size_t)tok * NKH + h) * 128 + c8;
                *(f32x4*)of = (f32x4){o[0], o[1], o[2], o[3]}; *(f32x4*)(of + 4) = (f32x4){o[4], o[5], o[6], o[7]};
                *(u32x4*)((isk ? KP : VP) + ((size_t)(b * NKH + h) * 256 + t) * 128 + c8) = w; }
            else *(u32x4*)((isk ? KS : VS) + ((size_t)(b * NKH + h) * 2304 + t) * 128 + c8) = w; }
    }
    for (int r4 = gw * 4; r4 < 8 * 256 * NKH; r4 += nw * 4) { const int r = r4 + sub; const int b = r / (256 * NKH), j = (r / NKH) & 255, h = r % NKH;
        const size_t o = ((size_t)(b * NKH + h) * 2304 + 2048 + j) * 128 + c8;
        const f32x4 k0 = *(const f32x4*)(ck + (size_t)r * 128 + c8), k1 = *(const f32x4*)(ck + (size_t)r * 128 + c8 + 4), v0 = *(const f32x4*)(cv + (size_t)r * 128 + c8), v1 = *(const f32x4*)(cv + (size_t)r * 128 + c8 + 4);
        const u32x4 wk = {cvt_pk_bf16(k0[0], k0[1]), cvt_pk_bf16(k0[2], k0[3]), cvt_pk_bf16(k1[0], k1[1]), cvt_pk_bf16(k1[2], k1[3])};
        const u32x4 wv = {cvt_pk_bf16(v0[0], v0[1]), cvt_pk_bf16(v0[2], v0[3]), cvt_pk_bf16(v1[0], v1[1]), cvt_pk_bf16(v1[2], v1[3])};
        *(u32x4*)(KS + o) = wk; *(u32x4*)(VS + o) = wv; }
}

__device__ __forceinline__ void phase_comb0(const Params& p) {
    const bf16_t* U = (const bf16_t*)(p.ws + WS_U); bf16_t* MIX = (bf16_t*)(p.ws + WS_H);
    const int lane = threadIdx.x & 63, gw = blockIdx.x * 8 + (threadIdx.x >> 6), nw = gridDim.x * 8;
    const int sub = lane >> 4, c8 = (lane & 15) * 8;
    const f32x4 onA = *(const f32x4*)(p.in[15] + c8), onB = *(const f32x4*)(p.in[15] + c8 + 4);
    for (int tok = gw; tok < NTOK; tok += 2 * nw) {
        const int tok2 = tok + nw; const bool has2 = tok2 < NTOK;
        bf16x8 vf[4], vb[4], vg[4];
#pragma unroll
        for (int q = 0; q < 4; ++q) { const int tk = (q < 2 || has2) ? ((q < 2) ? tok : tok2) : tok; const bf16_t* u = U + (size_t)tk * LDU0 + ((q & 1) * 4 + sub) * 128 + c8;
            vf[q] = *(const bf16x8*)(u + 1024); vb[q] = *(const bf16x8*)(u + 2048); vg[q] = *(const bf16x8*)(u + 4096); }
#pragma unroll
        for (int q = 0; q < 4; ++q) { if (q >= 2 && !has2) break;
            float sv[8], ss = 0.f;
#pragma unroll
            for (int j = 0; j < 8; ++j) { sv[j] = bf2f((bf16_t)vf[q][j]) + bf2f((bf16_t)vb[q][j]); ss += sv[j] * sv[j]; }
            ss = row16_sum(ss);
            const float rstd = rsqrtf(ss * (1.f / 128.f) + 1e-6f);
            float f[8];
#pragma unroll
            for (int j = 0; j < 8; ++j) f[j] = sv[j] * rstd * (j < 4 ? onA[j] : onB[j - 4]) * siluf(bf2f((bf16_t)vg[q][j]));
            const u32x4 w = {cvt_pk_bf16(f[0], f[1]), cvt_pk_bf16(f[2], f[3]), cvt_pk_bf16(f[4], f[5]), cvt_pk_bf16(f[6], f[7])};
            const int tk = q < 2 ? tok : tok2;
            *(u32x4*)(MIX + (size_t)tk * 2048 + ((q & 1) * 4 + sub) * 128 + c8) = w; }
    }
}

__device__ __forceinline__ void attn0_run(const Params& p, char* lds, bool samp, int b, int h, int qb) {
    char* ws = p.ws; asm volatile("" : "+s"(ws));
    const bf16_t* U = (const bf16_t*)(ws + WS_U); bf16_t* MIX = (bf16_t*)(ws + WS_H); const int kvh = h >> 2;
    const size_t row = samp ? NPTOK + (size_t)b * 2048 + qb * 256 : (size_t)b * 256;
    const size_t kvo = samp ? (size_t)(b * 2 + kvh) * 2304 * 128 : (size_t)(b * 2 + kvh) * 256 * 128;
    const bf16_t* Kp = (const bf16_t*)(ws + (samp ? WS_KS : WS_KP)) + kvo; const bf16_t* Vp = (const bf16_t*)(ws + (samp ? WS_VS : WS_VP)) + kvo;
    attn_body<LDU0>(U + row * LDU0 + 5120 + h * 128, Kp, Vp, U + row * LDU0 + 6656 + h * 128, MIX + row * 2048 + 1024 + h * 128,
                    samp ? 36 : 4, samp ? 4 : 0, samp ? 2048 : 0, 0, false, qb * 256, nullptr, lds);
}
__device__ __forceinline__ void attn_item1(const Params& p, char* lds, int a) {
    char* ws = p.ws; asm volatile("" : "+s"(ws));
    const bf16_t* U = (const bf16_t*)(ws + WS_U); bf16_t* MIX = (bf16_t*)(ws + WS_H);
    const bool samp = a < 1024;
    int b, kvh, h0, i0, ls, le; size_t row, kvo;
    if (samp) { const int x_ = a & 7, tb = (a >> 3) & 31, set_ = x_ + 8 * (a >> 8);
        b = set_ >> 2; kvh = set_ & 3; h0 = kvh * 4; i0 = tb * 64; row = NPTOK + (size_t)b * 2048 + i0; kvo = (size_t)(b * 4 + kvh) * 2304 * 128;
        ls = tb - 2 < 0 ? 0 : tb - 2; le = tb + 3 > 32 ? 32 : tb + 3;
    } else { const int a2 = a - 1024; b = a2 >> 4; h0 = a2 & 15; kvh = h0 >> 2; i0 = 0; row = (size_t)b * 256; kvo = (size_t)(b * 4 + kvh) * 256 * 128; ls = 0; le = 4; }
    const bf16_t* Kp = (const bf16_t*)(ws + (samp ? WS_KS : WS_KP)) + kvo; const bf16_t* Vp = (const bf16_t*)(ws + (samp ? WS_VS : WS_VP)) + kvo;
    attn_body<LDU1>(U + row * LDU1 + h0 * 128, Kp, Vp, U + row * LDU1 + 3072 + h0 * 128, MIX + row * 2048 + h0 * 128,
                    samp ? 4 + le - ls : 4, samp ? 4 : 0, samp ? 2048 : 0, ls, samp, i0, p.in[25] + h0, lds, samp);
}

template <class Epi>
__device__ __forceinline__ void phase_gemm(unsigned char* shm, const bf16_t* A, const bf16_t* Bt, int N, const Epi& E) {
    Gemm g; g.A = A; g.Bt = Bt; g.M = NTOK; g.N = N; g.K = 2048;
    StaticOrder S; S.init(NTOK, N, (int)gridDim.x, (int)blockIdx.x);
    gemm_phase<Epi, StaticOrder, false>((PG8_LAS unsigned char*)shm, g, S, E, nullptr);
}

#define XB_TMO      128
#define XB_XCNT(j)  (256  + 64 * (j))
#define XB_XSUB(j)  (1280 + 64 * (j))
#define XB_XGEN(j)  (2304 + 64 * (j))
#define XB_TOP      3328
#define XB_TOPGEN   3392
#define XCD_BAR_WORDS 3456
#define XB_SPIN_CAP (1u << 18)
#define LAS __attribute__((address_space(3)))

__device__ __forceinline__ unsigned xb_ld(unsigned* p)              { return __hip_atomic_load(p, __ATOMIC_RELAXED, __HIP_MEMORY_SCOPE_AGENT); }
__device__ __forceinline__ unsigned xb_add(unsigned* p, unsigned v) { return __hip_atomic_fetch_add(p, v, __ATOMIC_RELAXED, __HIP_MEMORY_SCOPE_AGENT); }
__device__ __forceinline__ unsigned xb_xcc_id() { return (unsigned)__builtin_amdgcn_s_getreg((3 << 11) | 20) & 0xFu; }
#define XB_SPIN(cond, bar) do { unsigned _sp = 0; while (cond) { __builtin_amdgcn_s_sleep(1); \
    if ((++_sp & 255u) == 0u) { if (xb_ld(&(bar)[XB_TMO])) break; if (_sp > XB_SPIN_CAP) { atomicAdd(&(bar)[XB_TMO], 1u); break; } } } } while (0)

struct XcdBarrier {
    unsigned* bar; unsigned x;
    volatile LAS unsigned* st;
};

__device__ __forceinline__ XcdBarrier xcd_barrier_post(unsigned* bar, volatile LAS unsigned* st) {
    XcdBarrier b; b.bar = bar; b.x = xb_xcc_id(); b.st = st;
    if (threadIdx.x == 0) (void)xb_add(&bar[XB_XCNT(b.x)], 1u);
    return b;
}
__device__ __forceinline__ void xcd_barrier_complete(unsigned* bar, unsigned x, unsigned& nloc, unsigned& nx) {
    const unsigned G = gridDim.x * gridDim.y * gridDim.z;
    unsigned sum, cnt, mine, sp = 0u;
    for (;;) {
        sum = 0u; cnt = 0u; mine = 0u;
#pragma unroll
        for (unsigned j = 0; j < 16; ++j) { const unsigned c = xb_ld(&bar[XB_XCNT(j)]); sum += c; cnt += (c > 0u) ? 1u : 0u; mine = (j == x) ? c : mine; }
        if (sum == G) break;
        __builtin_amdgcn_s_sleep(1);
        if ((++sp & 255u) == 0u) { if (xb_ld(&bar[XB_TMO])) break; if (sp > XB_SPIN_CAP) { atomicAdd(&bar[XB_TMO], 1u); break; } }
    }
    nloc = mine > 0u ? mine : 1u; nx = cnt > 0u ? cnt : 1u;
}

__device__ __forceinline__ void xcd_barrier(const XcdBarrier& b) {
    asm volatile("s_waitcnt vmcnt(0)" ::: "memory");
    __syncthreads();
    if (threadIdx.x == 0) {
        unsigned* bar = b.bar;
        __builtin_amdgcn_s_waitcnt(0);
        unsigned nloc = b.st[0], nx = b.st[1];
        if (nloc == 0u) { xcd_barrier_complete(bar, b.x, nloc, nx); b.st[0] = nloc; b.st[1] = nx; }
        const unsigned old = xb_add(&bar[XB_XSUB(b.x)], 1u);
        const unsigned gen = old / nloc;
        if (old + 1u == (gen + 1u) * nloc) {
            __builtin_amdgcn_fence(__ATOMIC_RELEASE, "agent");
            asm volatile("s_waitcnt vmcnt(0)" ::: "memory");
            const unsigned og = xb_add(&bar[XB_TOP], 1u);
            const unsigned tg = og / nx;
            if (og + 1u == (tg + 1u) * nx) xb_add(&bar[XB_TOPGEN], 1u);
            else XB_SPIN(xb_ld(&bar[XB_TOPGEN]) == tg, bar);
            __builtin_amdgcn_fence(__ATOMIC_ACQUIRE, "agent");
            xb_add(&bar[XB_XGEN(b.x)], 1u);
            asm volatile("s_waitcnt vmcnt(0)" ::: "memory");
        } else {
            XB_SPIN(xb_ld(&bar[XB_XGEN(b.x)]) == gen, bar);
            __builtin_amdgcn_fence(__ATOMIC_ACQUIRE, "agent");
            asm volatile("s_waitcnt vmcnt(0)" ::: "memory");
        }
    }
    __syncthreads();
}


constexpr int NPHASE = 12;
#define XB_NOW() do { XcdBarrier b_; b_.bar = (unsigned*)(p.ws + WS_BAR); b_.x = xb_xcc_id(); b_.st = (volatile LAS unsigned*)(shm + LDS_BYTES); xcd_barrier(b_); } while (0)
#if MK_MULTI
#define GSYNC(n) do { if (ph0 <= (n) && (n) + 1 < ph1) XB_NOW(); } while (0)
#define PH_ON(n) (ph0 <= (n) && (n) < ph1)
#else
#define GSYNC(n) do { if (ph0 <= (n) && (n) + 1 < ph1) XB_NOW(); } while (0)
#define PH_ON(n) (ph0 <= (n) && (n) < ph1)
#endif
__global__ void __launch_bounds__(512) mega(Params p, int ph0, int ph1) {
    extern __shared__ __attribute__((aligned(16))) unsigned char shm[];
    char* lds = (char*)shm;
    volatile LAS unsigned* xst = (volatile LAS unsigned*)(shm + LDS_BYTES);
    if (threadIdx.x == 0) { xst[0] = 0u; xst[1] = 0u; }
    __syncthreads();
    (void)xcd_barrier_post((unsigned*)(p.ws + WS_BAR), xst);
    if (p.ws == nullptr) cg::this_grid().sync();
#if (PHSEL >> 0) & 1
    if (PH_ON(0)) for (int rep = 0; rep <= ((REPMASK >> 0) & 1); ++rep) { if (rep) XB_NOW(); phase_prologue(p, lds);
        }
    GSYNC(0);
#endif
#if (PHSEL >> 1) & 1
    if (PH_ON(1)) for (int rep = 0; rep <= ((REPMASK >> 1) & 1); ++rep) { if (rep) XB_NOW(); phase_norm(p.in[0], p.in[1], p.in[10], (const float*)(p.ws + WS_MOD), (bf16_t*)(p.ws + WS_H));
        }
    GSYNC(1);
#endif
#if (PHSEL >> 2) & 1
    if (PH_ON(2)) for (int rep = 0; rep <= ((REPMASK >> 2) & 1); ++rep) { if (rep) XB_NOW(); { EpiU E; E.O = (bf16_t*)(p.ws + WS_U); E.ldc = LDU0; phase_gemm(shm, (const bf16_t*)(p.ws + WS_H), (const bf16_t*)(p.ws + WS_WT_IN0), 7680, E); }
        if (!rep) tail_fill_p2(p, lds);
        }
    GSYNC(2);
#endif
#if (PHSEL >> 3) & 1
    if (PH_ON(3)) for (int rep = 0; rep <= ((REPMASK >> 3) & 1); ++rep) { if (rep) XB_NOW(); phase_prep<0>(p);
        }
    GSYNC(3);
#endif
#if (PHSEL >> 4) & 1
    if (PH_ON(4)) for (int rep = 0; rep <= ((REPMASK >> 4) & 1); ++rep) { if (rep) XB_NOW();
            unsigned* qctr = (unsigned*)(p.ws + WS_BAR) + 3584;
            volatile LAS unsigned* slot = (volatile LAS unsigned*)(shm + LDS_BYTES + 8);
            const unsigned x0 = xb_xcc_id() & 7u;
            for (unsigned xo = 0; xo < 8u; ++xo) { const unsigned x = (x0 + xo) & 7u;
                for (;;) {
                    __syncthreads();
                    if (threadIdx.x == 0) *slot = __hip_atomic_fetch_add(qctr + 64 * x, 1u, __ATOMIC_RELAXED, __HIP_MEMORY_SCOPE_AGENT);
                    __syncthreads();
                    const int q = (int)*slot;
                    if (q >= 128 || rep) break;
                    if (q < 16 || (q >= 80 && q < 112)) hgrn_chain(p, lds, q < 16 ? (int)x * 16 + q : 128 + (int)x * 32 + (q - 80));
                    else if (q < 80) { const int j = q - 16, set_ = (int)x + 8 * (j >> 5), li = j & 31; attn0_run(p, lds, true, set_ >> 1, (set_ & 1) * 4 + (li >> 3), li & 7); }
                    else { const int a2 = (int)x * 16 + (q - 112); attn0_run(p, lds, false, a2 >> 3, a2 & 7, 0); }
                }
            }

        }
    GSYNC(4);
#endif
#if (PHSEL >> 5) & 1
    if (PH_ON(5)) for (int rep = 0; rep <= ((REPMASK >> 5) & 1); ++rep) { if (rep) XB_NOW(); phase_comb0(p);
        }
    GSYNC(5);
#endif
#if (PHSEL >> 6) & 1
    if (PH_ON(6)) for (int rep = 0; rep <= ((REPMASK >> 6) & 1); ++rep) { if (rep) XB_NOW(); { EpiRes E; E.Y = p.out; E.xp = p.in[0]; E.xs = p.in[1]; E.mod = (const float*)(p.ws + WS_MOD);
                  phase_gemm(shm, (const bf16_t*)(p.ws + WS_H), (const bf16_t*)(p.ws + WS_WT_OUT0), 2048, E); }
        if (!rep) tail_fill_p6(p, lds);
        }
    GSYNC(6);
#endif
#if (PHSEL >> 7) & 1
    if (PH_ON(7)) for (int rep = 0; rep <= ((REPMASK >> 7) & 1); ++rep) { if (rep) XB_NOW(); phase_norm(p.out, p.out + (size_t)NPTOK * 2048, p.in[18], (const float*)(p.ws + WS_MOD) + 9 * 6144, (bf16_t*)(p.ws + WS_H));
        }
    GSYNC(7);
#endif
#if (PHSEL >> 8) & 1
    if (PH_ON(8)) for (int rep = 0; rep <= ((REPMASK >> 8) & 1); ++rep) { if (rep) XB_NOW(); { EpiU E; E.O = (bf16_t*)(p.ws + WS_U); E.ldc = LDU1; phase_gemm(shm, (const bf16_t*)(p.ws + WS_H), (const bf16_t*)(p.ws + WS_WT_IN1), 5120, E); }
        }
    GSYNC(8);
#endif
#if (PHSEL >> 9) & 1
    if (PH_ON(9)) for (int rep = 0; rep <= ((REPMASK >> 9) & 1); ++rep) { if (rep) XB_NOW(); phase_prep<1>(p);
        }
    GSYNC(9);
#endif
#if (PHSEL >> 10) & 1
    if (PH_ON(10)) for (int rep = 0; rep <= ((REPMASK >> 10) & 1); ++rep) { if (rep) XB_NOW();
            for (int item = blockIdx.x; item < 1280; item += gridDim.x) { __syncthreads(); attn_item1(p, lds, item); }

        }
    GSYNC(10);
#endif
#if (PHSEL >> 11) & 1
    if (PH_ON(11)) for (int rep = 0; rep <= ((REPMASK >> 11) & 1); ++rep) { if (rep) XB_NOW(); { EpiRes E; E.Y = p.out; E.xp = p.out; E.xs = p.out + (size_t)NPTOK * 2048; E.mod = (const float*)(p.ws + WS_MOD) + 9 * 6144;
                   phase_gemm(shm, (const bf16_t*)(p.ws + WS_H), (const bf16_t*)(p.ws + WS_WT_OUT1), 2048, E); }
        }
    GSYNC(11);
#endif
}

extern "C" void kernel_launch(void* const* d_in, const int* in_sizes, int n_in, void* d_out, int out_size, void* d_ws, size_t ws_size, hipStream_t stream) {
    static int grid_blocks = 0;
    if (!grid_blocks) {
        if (ws_size < WS_END) { fprintf(stderr, "workspace too small: %zu < %zu\n", ws_size, WS_END); return; }
        if (hipFuncSetAttribute((const void*)mega, hipFuncAttributeMaxDynamicSharedMemorySize, LDS_BYTES + 16) != hipSuccess) { fprintf(stderr, "hipFuncSetAttribute failed\n"); return; }
        int dev = 0, cus = 0, per_cu = 0;
        hipGetDevice(&dev);
        hipDeviceGetAttribute(&cus, hipDeviceAttributeMultiprocessorCount, dev);
        hipOccupancyMaxActiveBlocksPerMultiprocessor(&per_cu, mega, 512, LDS_BYTES + 16);
        if (per_cu < 1) { fprintf(stderr, "occupancy query returned %d\n", per_cu); return; }
        if (cus != 256) { fprintf(stderr, "this kernel's static work split assumes 256 CUs (MI355X), found %d\n", cus); return; }
        grid_blocks = 256;
    }
    Params p{};
    for (int i = 0; i < 26; ++i) p.in[i] = (const float*)d_in[i];
    p.out = (float*)d_out; p.ws = (char*)d_ws;
    hipMemsetAsync((char*)d_ws + WS_BAR, 0, 16384, stream);
#if MK_MULTI
    for (int ph = 0; ph < NPHASE; ++ph) hipLaunchKernelGGL(mega, dim3(grid_blocks), dim3(512), LDS_BYTES + 16, stream, p, ph, ph + 1);
#else
    int ph0 = 0, ph1 = NPHASE;
    void* args[] = {&p, &ph0, &ph1};
    hipError_t e = hipLaunchCooperativeKernel((void*)mega, dim3(grid_blocks), dim3(512), args, LDS_BYTES + 16, stream);
    if (e != hipSuccess) fprintf(stderr, "cooperative launch failed: %s (grid %d)\n", hipGetErrorString(e), grid_blocks);
#endif
}
```

```cpp
#include <hip/hip_runtime.h>
#include <hip/hip_cooperative_groups.h>
#include <cstdio>
#include <cstdint>
namespace cg = cooperative_groups;

#ifndef PHSEL
#define PHSEL 0xFFF
#endif
#ifndef REPMASK
#define REPMASK 0
#endif
#ifndef MK_MULTI
#define MK_MULTI 0
#endif

constexpr int NTOK = 20480, NPTOK = 4096, DM = 2048;
constexpr int LDU0 = 7680, LDU1 = 5120;
constexpr size_t WS_WT_IN0 = 0;
constexpr size_t WS_WT_OUT0 = WS_WT_IN0 + (size_t)7680 * 2048 * 2;
constexpr size_t WS_WT_IN1 = WS_WT_OUT0 + (size_t)2048 * 2048 * 2;
constexpr size_t WS_WT_OUT1 = WS_WT_IN1 + (size_t)5120 * 2048 * 2;
constexpr size_t WS_MOD = WS_WT_OUT1 + (size_t)2048 * 2048 * 2;
constexpr size_t WS_LB = WS_MOD + (size_t)2 * 9 * 6144 * 4;
constexpr size_t WS_H = WS_LB + 8192;
constexpr size_t WS_U = WS_H + (size_t)NTOK * 2048 * 2;
constexpr size_t WS_KS = WS_U + (size_t)NTOK * 7680 * 2;
constexpr size_t WS_VS = WS_KS + (size_t)8 * 4 * 2304 * 128 * 2;
constexpr size_t WS_KP = WS_VS + (size_t)8 * 4 * 2304 * 128 * 2;
constexpr size_t WS_VP = WS_KP + (size_t)16 * 4 * 256 * 128 * 2;
constexpr size_t WS_BAR = WS_VP + (size_t)16 * 4 * 256 * 128 * 2;
constexpr size_t WS_END = WS_BAR + 16384;
constexpr size_t OUT_STATE = 41943040, OUT_L0K = 46137344, OUT_L0V = 47185920, OUT_L1K = 48234496, OUT_L1V = 50331648;
constexpr int O_LDS_OFF = 67584;
constexpr int LDS_BYTES = 2 * 38400 + 2 * 8704 + 6 * 8704;

struct Params { const float* in[26]; float* out; char* ws; };

namespace pg8 {
#define PG8_LAS __attribute__((address_space(3)))
typedef unsigned short bf16_t;
typedef short bf16x8 __attribute__((ext_vector_type(8)));
typedef float f32x4 __attribute__((ext_vector_type(4)));
typedef unsigned u32x4 __attribute__((ext_vector_type(4)));
constexpr int BM = 256, BK = 64, HALF = 128, HTB = HALF * BK * 2  , STAGE_BYTES = 8 * HTB, NXCD = 8, WGM = 8;

__host__ __device__ __forceinline__ int lds_byte(int r, int c) { const int st = (r >> 4) * 2 + (c >> 5), rr = r & 15, cc = c & 31, ob = rr * 64 + cc * 2; return st * 1024 + (ob ^ (((ob >> 9) & 1) << 5)); }
__host__ __device__ __forceinline__ void stage_rc(int b, int& R, int& C) { const int st = b / 1024, sb = b % 1024, swz = sb ^ (((sb >> 9) & 1) << 5); R = (st >> 1) * 16 + swz / 64; C = (st & 1) * 32 + (swz % 64) / 2; }
__host__ __device__ __forceinline__ int perm32(int rho) { const int n = rho >> 4, i = rho & 15; return 8 * (i >> 2) + 4 * n + (i & 3); }

struct Unit { int pm, pn; };
struct Gemm { const bf16_t* A; const bf16_t* Bt; int M, N, K; };

struct StaticOrder {
    int nM, nN, nwg, G, c;
    __host__ __device__ void init(int M, int N, int G_, int c_) { nM = M / BM; nN = N / BM; nwg = nM * nN; G = G_; c = c_; }
    __host__ __device__ bool next(int i, Unit& u) const {
        const long L = (long)i * G + c; if (L >= nwg) return false;
        int wgid = (int)L; { const int q = nwg / NXCD, r = nwg % NXCD, xcd = wgid % NXCD, off = wgid / NXCD; wgid = (xcd < r ? xcd * (q + 1) : r * (q + 1) + (xcd - r) * q) + off; }
        const int nig = WGM * nN, gid = wgid / nig, fm = gid * WGM, gsz = (nM - fm) < WGM ? (nM - fm) : WGM;
        u.pm = fm + ((wgid % nig) % gsz); u.pn = (wgid % nig) / gsz; return true;
    }
    __device__ __forceinline__ void a_ready(const Unit&) const {}
    __device__ __forceinline__ void done(const Unit&) const {}
};
__device__ __forceinline__ unsigned cvt_pk_bf16(float lo, float hi) { unsigned r; asm volatile("v_cvt_pk_bf16_f32 %0, %1, %2" : "=v"(r) : "v"(lo), "v"(hi)); return r; }


template <class Epi, class Sched, bool STAMP = false>
__device__ __forceinline__ void gemm_phase(PG8_LAS unsigned char* lds, const Gemm g, const Sched& S, const Epi& E, unsigned long long* stamps) {
    const int tid = threadIdx.x, wid = __builtin_amdgcn_readfirstlane(tid >> 6), lane = tid & 63, wr = wid >> 2, wc = wid & 3, fr = lane & 15, fq = lane >> 4;
    const int K = g.K, nt = K / BK;
    int ts_lo = 0, ts_hi = 0, nts = 0; const unsigned long long rt_entry = STAMP ? (unsigned long long)wall_clock64() : 0ull;
#define PG8_STAMP() do { if (STAMP && wid == 0 && nts < 64) { const unsigned long long _c = (unsigned long long)clock64(); \
        ts_lo = (lane == nts) ? (int)(unsigned)_c : ts_lo; ts_hi = (lane == nts) ? (int)(unsigned)(_c >> 32) : ts_hi; ++nts; } } while (0)
    PG8_STAMP();
    unsigned voffA[2], voffB[2];
#pragma unroll
    for (int i = 0; i < 2; ++i) { int R, C; stage_rc(tid * 16 + i * 8192, R, C); const int Rb = Epi::PERM ? ((R & ~31) + perm32(R & 31)) : R;
        voffA[i] = (unsigned)(R * K + C) * 2u; voffB[i] = (unsigned)(Rb * K + C) * 2u; }
    const size_t kstep = (size_t)(BK * 2);
    const size_t hstep = (size_t)HALF * K * 2;
    const size_t tstep = 2 * hstep;
    const unsigned ldsw = (unsigned)wid * 1024u;
    const int aoff = lds_byte(wr * 64 + fr, fq * 8), boff = lds_byte(wc * 32 + fr, fq * 8);
#define PG8_SA(b, h) (((b) * 2 + (h)) * HTB)
#define PG8_SB(b, h) ((4 + (b) * 2 + (h)) * HTB)
#define PG8_STAGE(bufoff, gbase, voff) do { _Pragma("unroll") for (int _i = 0; _i < 2; ++_i) \
        __builtin_amdgcn_global_load_lds((const unsigned*)((const char*)(gbase) + (voff)[_i]), (PG8_LAS unsigned*)(lds + (bufoff) + ldsw + _i * 8192), 16, 0, 0); } while (0)
#define PG8_LDA(dst, b, h) do { _Pragma("unroll") for (int m = 0; m < 4; ++m) _Pragma("unroll") for (int k = 0; k < 2; ++k) dst[m][k] = *(const PG8_LAS bf16x8*)(lds + PG8_SA(b, h) + aoff + m * 2048 + k * 1024); } while (0)
#define PG8_LDB(dst, b, h) do { _Pragma("unroll") for (int n = 0; n < 2; ++n) _Pragma("unroll") for (int k = 0; k < 2; ++k) dst[n][k] = *(const PG8_LAS bf16x8*)(lds + PG8_SB(b, h) + boff + n * 2048 + k * 1024); } while (0)
#define PG8_MMA(ai, bj, At, Bt) do { __builtin_amdgcn_s_setprio(1); _Pragma("unroll") for (int m = 0; m < 4; ++m) _Pragma("unroll") for (int n = 0; n < 2; ++n) _Pragma("unroll") for (int k = 0; k < 2; ++k) \
        acc[ai][bj][m][n] = __builtin_amdgcn_mfma_f32_16x16x32_bf16(Bt[n][k], At[m][k], acc[ai][bj][m][n], 0, 0, 0); __builtin_amdgcn_s_setprio(0); } while (0)
#define PG8_WAIT_V(n) asm volatile("s_waitcnt vmcnt(" #n ")" ::: "memory")
#define PG8_WAIT_L(n) asm volatile("s_waitcnt lgkmcnt(" #n ")" ::: "memory")
#define PG8_BAR __builtin_amdgcn_s_barrier()
#define PG8_SCHED __builtin_amdgcn_sched_barrier(0)
    Unit cur, nxt; int ui = 0;
    if (!S.next(0, cur)) return;
    f32x4 acc[2][2][4][2];
#pragma unroll
    for (int a = 0; a < 2; ++a)
#pragma unroll
        for (int b = 0; b < 2; ++b)
#pragma unroll
            for (int m = 0; m < 4; ++m)
#pragma unroll
                for (int n = 0; n < 2; ++n) acc[a][b][m][n] = (f32x4){0.f, 0.f, 0.f, 0.f};
    bf16x8 At[4][2], B0[2][2], B1[2][2];
    const char* cA = (const char*)g.A + (size_t)cur.pm * tstep; const char* cB = (const char*)g.Bt + (size_t)cur.pn * tstep;
    S.a_ready(cur);
    PG8_STAGE(PG8_SB(0, 0), cB, voffB); PG8_STAGE(PG8_SA(0, 0), cA, voffA); PG8_STAGE(PG8_SB(0, 1), cB + hstep, voffB); PG8_STAGE(PG8_SA(0, 1), cA + hstep, voffA);
    if (wr == 1) PG8_BAR;
    PG8_WAIT_V(4); PG8_BAR;
    PG8_STAGE(PG8_SB(1, 0), cB + kstep, voffB); PG8_STAGE(PG8_SA(1, 0), cA + kstep, voffA); PG8_STAGE(PG8_SB(1, 1), cB + hstep + kstep, voffB);
    PG8_WAIT_V(6); PG8_BAR;
    PG8_STAMP();
    for (;;) {
        const bool has_next = S.next(ui + 1, nxt);
        const char* nA = has_next ? (const char*)g.A + (size_t)nxt.pm * tstep : cA; const char* nB = has_next ? (const char*)g.Bt + (size_t)nxt.pn * tstep : cB;
        for (int t = 0; t < nt; t += 2) {
            const bool last = (t == nt - 2);
            const char* a1 = cA + (size_t)(t + 1) * kstep;
            const char* a2 = last ? nA : cA + (size_t)(t + 2) * kstep; const char* b2 = last ? nB : cB + (size_t)(t + 2) * kstep;
            const char* a3 = a2 + kstep; const char* b3 = b2 + kstep;
            if (last && has_next) S.a_ready(nxt);
            PG8_LDB(B0, 0, 0); PG8_SCHED; PG8_LDA(At, 0, 0); PG8_STAGE(PG8_SA(1, 1), a1 + hstep, voffA);
            PG8_WAIT_L(8); PG8_BAR; PG8_WAIT_L(0); PG8_MMA(0, 0, At, B0); PG8_BAR; PG8_SCHED;
            PG8_LDB(B1, 0, 1); PG8_STAGE(PG8_SB(0, 0), b2, voffB);
            PG8_BAR; PG8_WAIT_L(0); PG8_MMA(0, 1, At, B1); PG8_BAR;
            PG8_LDA(At, 0, 1); PG8_STAGE(PG8_SA(0, 0), a2, voffA);
            PG8_BAR; PG8_WAIT_L(0); PG8_MMA(1, 0, At, B0); PG8_BAR; PG8_SCHED;
            PG8_STAGE(PG8_SB(0, 1), b2 + hstep, voffB);
            PG8_WAIT_V(6); PG8_BAR; PG8_MMA(1, 1, At, B1); PG8_BAR;
            PG8_LDB(B0, 1, 0); PG8_SCHED; PG8_LDA(At, 1, 0); PG8_STAGE(PG8_SA(0, 1), a2 + hstep, voffA);
            PG8_WAIT_L(8); PG8_BAR; PG8_WAIT_L(0); PG8_MMA(0, 0, At, B0); PG8_BAR; PG8_SCHED;
            PG8_LDB(B1, 1, 1); PG8_STAGE(PG8_SB(1, 0), b3, voffB);
            PG8_BAR; PG8_WAIT_L(0); PG8_MMA(0, 1, At, B1); PG8_BAR;
            PG8_LDA(At, 1, 1); PG8_STAGE(PG8_SA(1, 0), a3, voffA);
            PG8_BAR; PG8_WAIT_L(0); PG8_MMA(1, 0, At, B0); PG8_BAR; PG8_SCHED;
            PG8_STAGE(PG8_SB(1, 1), b3 + hstep, voffB);
            PG8_WAIT_V(6); PG8_BAR; PG8_MMA(1, 1, At, B1); PG8_BAR;
        }
        PG8_STAMP();
        if constexpr (!Epi::AFTER_DRAIN) { E(acc, cur, wr, wc, fr, fq); S.done(cur); }
        PG8_STAMP();
        if (!has_next) break;
#pragma unroll
        for (int a = 0; a < 2; ++a)
#pragma unroll
            for (int b = 0; b < 2; ++b)
#pragma unroll
                for (int m = 0; m < 4; ++m)
#pragma unroll
                    for (int n = 0; n < 2; ++n) acc[a][b][m][n] = (f32x4){0.f, 0.f, 0.f, 0.f};
        cur = nxt; cA = nA; cB = nB; ++ui;
    }
    PG8_WAIT_V(0);
    if (wr == 0) PG8_BAR;
    PG8_BAR;
    if constexpr (Epi::AFTER_DRAIN) { E.fused(acc, cur, wr, wc, fr, fq, lds, wid, lane); S.done(cur); }
    PG8_STAMP();
    if (STAMP && wid == 0) { stamps[lane] = lane < nts ? (((unsigned long long)(unsigned)ts_hi << 32) | (unsigned)ts_lo) : 0ull;
        if (lane == 62) stamps[62] = rt_entry; if (lane == 63) stamps[63] = (unsigned long long)wall_clock64(); }
#undef PG8_STAMP
#undef PG8_SA
#undef PG8_SB
#undef PG8_STAGE
#undef PG8_LDA
#undef PG8_LDB
#undef PG8_MMA
#undef PG8_WAIT_V
#undef PG8_WAIT_L
#undef PG8_BAR
#undef PG8_SCHED
}
}
using namespace pg8;
typedef float f32x16 __attribute__((ext_vector_type(16)));
typedef short s16x4 __attribute__((ext_vector_type(4)));
typedef unsigned u32x2 __attribute__((ext_vector_type(2)));

__device__ __forceinline__ float bf2f(bf16_t x) { return __uint_as_float(((unsigned)x) << 16); }
__device__ __forceinline__ bf16_t f2bf(float f) { unsigned u = __float_as_uint(f); u += 0x7FFFu + ((u >> 16) & 1u); return (bf16_t)(u >> 16); }
template <int CTRL> __device__ __forceinline__ float dpp_f(float v) { return __int_as_float(__builtin_amdgcn_update_dpp(0, __float_as_int(v), CTRL, 0xF, 0xF, true)); }
__device__ __forceinline__ float row16_sum(float v) {
    v += dpp_f<0xB1>(v);
    v += dpp_f<0x4E>(v);
    v += dpp_f<0x141>(v);
    v += dpp_f<0x140>(v);
    return v;
}
__device__ __forceinline__ float wave_sum(float v) { v = row16_sum(v); v += __shfl_xor(v, 16); v += __shfl_xor(v, 32); return v; }
__device__ __forceinline__ float fexp(float x) { return __builtin_amdgcn_exp2f(x * 1.4426950408889634f); }
__device__ __forceinline__ float flog(float x) { return __builtin_amdgcn_logf(x) * 0.6931471805599453f; }
__device__ __forceinline__ float siluf(float a) { return a * __builtin_amdgcn_rcpf(1.f + __expf(-a)); }

struct EpiU {
    static constexpr bool PERM = true, AFTER_DRAIN = false;
    bf16_t* O; int ldc;
    __device__ __forceinline__ void operator()(const f32x4 (&acc)[2][2][4][2], const Unit& u, int wr, int wc, int fr, int fq) const {
        const int row0 = u.pm * BM + wr * 64 + fr, col0 = u.pn * BM + wc * 32 + 8 * fq;
#pragma unroll
        for (int ai = 0; ai < 2; ++ai)
#pragma unroll
            for (int m = 0; m < 4; ++m) { bf16_t* rowp = O + (size_t)(row0 + ai * HALF + m * 16) * ldc + col0;
#pragma unroll
                for (int bj = 0; bj < 2; ++bj) { const f32x4 v0 = acc[ai][bj][m][0], v1 = acc[ai][bj][m][1];
                    u32x4 w = {cvt_pk_bf16(v0[0], v0[1]), cvt_pk_bf16(v0[2], v0[3]), cvt_pk_bf16(v1[0], v1[1]), cvt_pk_bf16(v1[2], v1[3])};
                    *(u32x4*)(rowp + bj * HALF) = w; } }
    }
};
struct EpiRes {
    static constexpr bool PERM = false, AFTER_DRAIN = false;
    float* Y; const float* xp; const float* xs; const float* mod;
    __device__ __forceinline__ void operator()(const f32x4 (&acc)[2][2][4][2], const Unit& u, int wr, int wc, int fr, int fq) const {
        const int row0 = u.pm * BM + wr * 64 + fr, col0 = u.pn * BM + wc * 32 + 4 * fq;
        const bool prompt = u.pm < 16; const int j = prompt ? 0 : 1 + ((u.pm - 16) >> 3);
        const float* gp = mod + j * 6144 + 4096 + col0;
        f32x4 gv[2][2];
#pragma unroll
        for (int bj = 0; bj < 2; ++bj)
#pragma unroll
            for (int n = 0; n < 2; ++n) gv[bj][n] = *(const f32x4*)(gp + bj * HALF + n * 16);
#pragma unroll
        for (int ai = 0; ai < 2; ++ai) {
            f32x4 xb[4][2][2];
#pragma unroll
            for (int m = 0; m < 4; ++m) { const int r = row0 + ai * HALF + m * 16;
                const float* bp = (prompt ? xp + (size_t)r * 2048 : xs + (size_t)(r - NPTOK) * 2048) + col0;
#pragma unroll
                for (int bj = 0; bj < 2; ++bj)
#pragma unroll
                    for (int n = 0; n < 2; ++n) xb[m][bj][n] = *(const f32x4*)(bp + bj * HALF + n * 16); }
#pragma unroll
            for (int m = 0; m < 4; ++m) { const int r = row0 + ai * HALF + m * 16; float* yp = Y + (size_t)r * 2048 + col0;
#pragma unroll
                for (int bj = 0; bj < 2; ++bj)
#pragma unroll
                    for (int n = 0; n < 2; ++n) *(f32x4*)(yp + bj * HALF + n * 16) = xb[m][bj][n] + gv[bj][n] * acc[ai][bj][m][n]; }
        }
    }
};

constexpr int QBLK = 32, KVBLK = 64;
constexpr float SCALE = 0.088388347648318440f;
constexpr float THR = 8.f;
constexpr size_t SHM_V = KVBLK * 128 * 2, SHM_K = KVBLK * 128 * 2;
constexpr int Q_LDS_OFF = 2 * 16384 + 2 * 16384 + 8 * 64 * 4;
#define KSWZ(row, colB) ((row) * 256 + ((colB) ^ (((row) & 7) << 4)))
#define SBAR() __builtin_amdgcn_sched_barrier(0)
__device__ __forceinline__ int crow(int r, int hi) { return (r & 3) + 8 * (r >> 2) + 4 * hi; }

__device__ __forceinline__ void partialSM(f32x16& p0, f32x16& p1, float& m_reg, float& mn, float& alpha, bool domask, int kd, int hi) {
  constexpr float C = SCALE * 1.4426950408889634f;
  if (domask) {
#pragma unroll
    for (int r = 0; r < 16; ++r) { const int kk = kd + crow(r, hi); p0[r] = (kk >= -128 && kk <= 128) ? p0[r] : -1e30f; p1[r] = (kk + 32 >= -128 && kk + 32 <= 128) ? p1[r] : -1e30f; }
  }
  float pmax = p0[0];
#pragma unroll
  for (int r = 1; r < 16; ++r) pmax = fmaxf(pmax, p0[r]);
#pragma unroll
  for (int r = 0; r < 16; ++r) pmax = fmaxf(pmax, p1[r]);
  { auto rr = __builtin_amdgcn_permlane32_swap(__float_as_uint(pmax), __float_as_uint(pmax), false, false);
    pmax = fmaxf(__uint_as_float(rr[0]), __uint_as_float(rr[1])); }
  if (__builtin_expect(__all(pmax - m_reg <= THR / SCALE), 1)) { mn = m_reg; alpha = 1.f; }
  else { mn = fmaxf(m_reg, pmax); alpha = __builtin_amdgcn_exp2f((m_reg - mn) * C); m_reg = mn; }
  float mnC = -mn * C;
#pragma unroll
  for (int r = 0; r < 16; ++r) p0[r] = fmaf(p0[r], C, mnC);
#pragma unroll
  for (int r = 0; r < 16; ++r) p1[r] = fmaf(p1[r], C, mnC);
#pragma unroll
  for (int r = 0; r < 16; ++r) p0[r] = __builtin_amdgcn_exp2f(p0[r]);
}
__device__ __forceinline__ void finishSM(f32x16& p0, f32x16& p1, float alpha, float& l_reg, bf16x8& pa0, bf16x8& pa1, bf16x8& pa2, bf16x8& pa3) {
#pragma unroll
  for (int r = 0; r < 16; ++r) p1[r] = __builtin_amdgcn_exp2f(p1[r]);
  float ps = 0;
#pragma unroll
  for (int r = 0; r < 16; ++r) ps += p0[r];
#pragma unroll
  for (int r = 0; r < 16; ++r) ps += p1[r];
  { auto rr = __builtin_amdgcn_permlane32_swap(__float_as_uint(ps), __float_as_uint(ps), false, false);
    ps = __uint_as_float(rr[0]) + __uint_as_float(rr[1]); }
  l_reg = l_reg * alpha + ps;
#define PK4(P, BASE, OUT) do { unsigned a0 = cvt_pk_bf16(P[BASE + 0], P[BASE + 1]), a1 = cvt_pk_bf16(P[BASE + 2], P[BASE + 3]);   \
    unsigned b0 = cvt_pk_bf16(P[BASE + 4], P[BASE + 5]), b1 = cvt_pk_bf16(P[BASE + 6], P[BASE + 7]);                              \
    auto r0 = __builtin_amdgcn_permlane32_swap(a0, b0, false, false); auto r1 = __builtin_amdgcn_permlane32_swap(a1, b1, false, false); \
    u32x4 w = {r0[0], r1[0], r0[1], r1[1]}; OUT = *reinterpret_cast<bf16x8*>(&w); } while (0)
  PK4(p0, 0, pa0); PK4(p0, 8, pa1); PK4(p1, 0, pa2); PK4(p1, 8, pa3);
#undef PK4
}
__device__ __forceinline__ void qkt(f32x16& p0, f32x16& p1, const bf16_t* Ks, const bf16x8* qr, int r32, int hi) {
  p0 = f32x16{}; p1 = f32x16{};
#pragma unroll
  for (int d0 = 0; d0 < 8; ++d0) { int cb = (d0 * 16 + hi * 8) * 2; const bf16x8 qf = qr[d0];
    bf16x8 b0 = *reinterpret_cast<const bf16x8*>((const char*)Ks + KSWZ(r32, cb));
    bf16x8 b1 = *reinterpret_cast<const bf16x8*>((const char*)Ks + KSWZ(32 + r32, cb));
    p0 = __builtin_amdgcn_mfma_f32_32x32x16_bf16(b0, qf, p0, 0, 0, 0);
    p1 = __builtin_amdgcn_mfma_f32_32x32x16_bf16(b1, qf, p1, 0, 0, 0); }
}
__device__ __forceinline__ int v_st(int k, int c) { const int kk = (k & ~0xC) | ((k & 4) << 1) | ((k & 8) >> 1); return ((kk >> 3) * 4 + (c >> 5)) * 512 + ((kk & 7) * 32 + (c & 31)) * 2; }
__device__ __forceinline__ int v_rd_base(int lane) { return ((lane & 3) << 3) | (((lane >> 2) & 3) << 6) | (((lane >> 4) & 1) << 5) | (((lane >> 5) & 1) << 8); }
constexpr int v_rd_off(int d0, int ks, int half) { return d0 * 512 + ks * 4096 + half * 2048; }
template <int OFF> __device__ __forceinline__ s16x4 tr_read(int vb) {
  s16x4 r; asm volatile("ds_read_b64_tr_b16 %0, %1 offset:%2" : "=&v"(r) : "v"(vb), "i"(OFF) : "memory"); return r;
}
template <int D0> __device__ __forceinline__ void pv_one(f32x16& od, int vb, bf16x8 pa0, bf16x8 pa1, bf16x8 pa2, bf16x8 pa3) {
  const s16x4 l0 = tr_read<v_rd_off(D0, 0, 0)>(vb), h0 = tr_read<v_rd_off(D0, 0, 1)>(vb), l1 = tr_read<v_rd_off(D0, 1, 0)>(vb), h1 = tr_read<v_rd_off(D0, 1, 1)>(vb);
  const s16x4 l2 = tr_read<v_rd_off(D0, 2, 0)>(vb), h2 = tr_read<v_rd_off(D0, 2, 1)>(vb), l3 = tr_read<v_rd_off(D0, 3, 0)>(vb), h3 = tr_read<v_rd_off(D0, 3, 1)>(vb);
  asm volatile("s_waitcnt lgkmcnt(0)" ::: "memory"); SBAR();
#define PK(L, H) (bf16x8){L[0], L[1], L[2], L[3], H[0], H[1], H[2], H[3]}
  od = __builtin_amdgcn_mfma_f32_32x32x16_bf16(pa0, PK(l0, h0), od, 0, 0, 0);
  od = __builtin_amdgcn_mfma_f32_32x32x16_bf16(pa1, PK(l1, h1), od, 0, 0, 0);
  od = __builtin_amdgcn_mfma_f32_32x32x16_bf16(pa2, PK(l2, h2), od, 0, 0, 0);
  od = __builtin_amdgcn_mfma_f32_32x32x16_bf16(pa3, PK(l3, h3), od, 0, 0, 0);
#undef PK
}
__device__ __forceinline__ void pv_d0(f32x16* o, int vb, bf16x8 pa0, bf16x8 pa1, bf16x8 pa2, bf16x8 pa3) {
  pv_one<0>(o[0], vb, pa0, pa1, pa2, pa3); pv_one<1>(o[1], vb, pa0, pa1, pa2, pa3); pv_one<2>(o[2], vb, pa0, pa1, pa2, pa3); pv_one<3>(o[3], vb, pa0, pa1, pa2, pa3);
}

template <int LDQ>
__device__ __forceinline__ void attn_body(const bf16_t* __restrict__ Qb, const bf16_t* __restrict__ Kh, const bf16_t* __restrict__ Vh,
                                          const bf16_t* __restrict__ Gb, bf16_t* __restrict__ Ob, const int NT, const int nctx, const int ctx_base,
                                          const int lat_start, const bool window, const int i0, const float* __restrict__ sinkp, char* lds, const bool pack4 = false) {
  constexpr int LDK = 128;
  int tid_ = threadIdx.x; asm volatile("" : "+v"(tid_));
  const int tid = tid_, wid = __builtin_amdgcn_readfirstlane(tid >> 6), lane = tid & 63, r32 = lane & 31, hi = lane >> 5;
  bf16_t* V_lds = (bf16_t*)lds; bf16_t* K_lds = (bf16_t*)(lds + 2 * SHM_V);
  float* ws = (float*)(lds + 2 * SHM_V + 2 * SHM_K) + wid * 64; float* li_l = ws; float* al_l = ws + 32;
  float m_reg = -1e30f, l_reg = 0; f32x16 o[4] = {};
  const int wrow = pack4 ? (wid & 1) * 32 : wid * 32, whead = pack4 ? (wid >> 1) * 128 : 0;
  bf16x8 qr[8];
  { const bf16_t* Qw = Qb + (long)(wrow + r32) * LDQ + whead + hi * 8;
#pragma unroll
    for (int d0 = 0; d0 < 8; ++d0) qr[d0] = *reinterpret_cast<const bf16x8*>(Qw + d0 * 16); }
  const int sr = tid >> 4, sc = (tid & 15) * 8, vst0 = v_st(sr, sc), vst1 = v_st(32 + sr, sc);
  const int vb0 = (int)(uintptr_t)V_lds + v_rd_base(lane);
  const int qpos = i0 + wrow + r32, qw = i0 + wrow;
  struct { bf16x8 vs0, vs1, ks0, ks1; } sr_[2];
#define KOFF(j) ((j) < nctx ? ctx_base + (j) * 64 : (lat_start + (j) - nctx) * 64)
#define DOMASK(j, k0) (window && (j) >= nctx && !(((k0) + 63 - qw <= 128) && (qw + 31 - (k0) <= 128)))
#define SLOAD(i, k0) do { sr_[i].vs0 = *(const bf16x8*)(&Vh[(long)((k0) + sr) * LDK + sc]); sr_[i].vs1 = *(const bf16x8*)(&Vh[(long)((k0) + 32 + sr) * LDK + sc]); \
    sr_[i].ks0 = *(const bf16x8*)(&Kh[(long)((k0) + sr) * LDK + sc]); sr_[i].ks1 = *(const bf16x8*)(&Kh[(long)((k0) + 32 + sr) * LDK + sc]); } while (0)
#define SWRITE(b, i) do { *(bf16x8*)((char*)V_lds + (b) * SHM_V + vst0) = sr_[i].vs0;          \
    *(bf16x8*)((char*)V_lds + (b) * SHM_V + vst1) = sr_[i].vs1; int kc = sc * 2;               \
    *(bf16x8*)((char*)K_lds + (b) * SHM_K + KSWZ(sr, kc)) = sr_[i].ks0;                       \
    *(bf16x8*)((char*)K_lds + (b) * SHM_K + KSWZ(32 + sr, kc)) = sr_[i].ks1; } while (0)
#define SWAIT() asm volatile("s_waitcnt vmcnt(4)" ::: "memory")
#define RESC(a) do { if (__any((a) < 1.f)) { if (hi == 0) al_l[r32] = (a); asm volatile("s_waitcnt lgkmcnt(0)" ::: "memory"); \
    _Pragma("unroll") for (int d = 0; d < 4; ++d) _Pragma("unroll") for (int r = 0; r < 16; ++r) o[d][r] *= al_l[crow(r, hi)]; } } while (0)
  f32x16 pA0, pA1, pB0, pB1; float mnA, mnB, alA, alB; bf16x8 pa0, pa1, pa2, pa3;
  constexpr int SE = 0, SO = 1;
  int kcur = KOFF(0);
  SLOAD(SE, kcur); asm volatile("s_waitcnt vmcnt(0)" ::: "memory"); SWRITE(0, SE); __syncthreads();
  qkt(pA0, pA1, K_lds, qr, r32, hi); partialSM(pA0, pA1, m_reg, mnA, alA, DOMASK(0, kcur), kcur - qpos, hi);
  { const int k1 = KOFF(1); SLOAD(SO, k1); } if (2 < NT) { const int k2 = KOFF(2); SLOAD(SE, k2); }
  SWAIT(); SWRITE(1, SO); __syncthreads();
  for (int j = 1; j + 1 < NT; j += 2) {
    SBAR(); qkt(pB0, pB1, (bf16_t*)((char*)K_lds + SHM_K), qr, r32, hi);
    finishSM(pA0, pA1, alA, l_reg, pa0, pa1, pa2, pa3); SBAR();
    if (j + 2 < NT) { const int kn = KOFF(j + 2); SLOAD(SO, kn); } SBAR();
    { const int kj = KOFF(j); pv_d0(o, vb0, pa0, pa1, pa2, pa3); partialSM(pB0, pB1, m_reg, mnB, alB, DOMASK(j, kj), kj - qpos, hi); }
    __syncthreads(); SWAIT(); SWRITE(0, SE);
    RESC(alB); __syncthreads();
    SBAR(); qkt(pA0, pA1, K_lds, qr, r32, hi);
    finishSM(pB0, pB1, alB, l_reg, pa0, pa1, pa2, pa3); SBAR();
    if (j + 3 < NT) { const int kn = KOFF(j + 3); SLOAD(SE, kn); } SBAR();
    { const int kj = KOFF(j + 1); pv_d0(o, vb0 + (int)SHM_V, pa0, pa1, pa2, pa3); partialSM(pA0, pA1, m_reg, mnA, alA, DOMASK(j + 1, kj), kj - qpos, hi); }
    __syncthreads(); SWAIT(); SWRITE(1, SO);
    RESC(alA); __syncthreads();
  }
  if (NT & 1) {
    finishSM(pA0, pA1, alA, l_reg, pa0, pa1, pa2, pa3); SBAR();
    pv_d0(o, vb0, pa0, pa1, pa2, pa3);
  } else {
    SBAR(); qkt(pB0, pB1, (bf16_t*)((char*)K_lds + SHM_K), qr, r32, hi);
    finishSM(pA0, pA1, alA, l_reg, pa0, pa1, pa2, pa3); SBAR();
    { const int kj = KOFF(NT - 1); pv_d0(o, vb0, pa0, pa1, pa2, pa3); partialSM(pB0, pB1, m_reg, mnB, alB, DOMASK(NT - 1, kj), kj - qpos, hi); }
    __syncthreads(); RESC(alB);
    finishSM(pB0, pB1, alB, l_reg, pa0, pa1, pa2, pa3); SBAR();
    pv_d0(o, vb0 + (int)SHM_V, pa0, pa1, pa2, pa3);
  }
  if (sinkp) l_reg += __builtin_amdgcn_exp2f(sinkp[pack4 ? (wid >> 1) : 0] * 1.4426950408889634f - m_reg * (SCALE * 1.4426950408889634f));
  if (hi == 0) li_l[r32] = l_reg; asm volatile("s_waitcnt lgkmcnt(0)" ::: "memory");
  const bf16_t* Gw = Gb + (long)wrow * LDQ + whead; bf16_t* Ow = Ob + (long)wrow * 2048 + whead;
  char* ot = lds + O_LDS_OFF + wid * 8704;
  bf16x8 gvr[8];
#pragma unroll
  for (int it = 0; it < 8; ++it) gvr[it] = *(const bf16x8*)(Gw + (long)(it * 4 + (lane >> 4)) * LDQ + (lane & 15) * 8);
  float rlv[16];
#pragma unroll
  for (int r = 0; r < 16; ++r) rlv[r] = li_l[crow(r, hi)];
  asm volatile("s_waitcnt lgkmcnt(0)" ::: "memory"); __builtin_amdgcn_sched_barrier(0);
#pragma unroll
  for (int r = 0; r < 16; ++r) { const int orow = crow(r, hi); const float rl = __builtin_amdgcn_rcpf(rlv[r]);
    const unsigned p01 = cvt_pk_bf16(o[0][r] * rl, o[1][r] * rl), p23 = cvt_pk_bf16(o[2][r] * rl, o[3][r] * rl);
    char* op = ot + orow * 272 + r32 * 2;
    *(bf16_t*)(op) = (bf16_t)(p01 & 0xffffu); *(bf16_t*)(op + 64) = (bf16_t)(p01 >> 16);
    *(bf16_t*)(op + 128) = (bf16_t)(p23 & 0xffffu); *(bf16_t*)(op + 192) = (bf16_t)(p23 >> 16); }
  asm volatile("s_waitcnt lgkmcnt(0)" ::: "memory");
  bf16x8 ovr[8];
#pragma unroll
  for (int it = 0; it < 8; ++it) ovr[it] = *(const bf16x8*)(ot + (it * 4 + (lane >> 4)) * 272 + (lane & 15) * 16);
  asm volatile("s_waitcnt lgkmcnt(0)" ::: "memory"); __builtin_amdgcn_sched_barrier(0);
#pragma unroll
  for (int it = 0; it < 8; ++it) { const int row = it * 4 + (lane >> 4), c8 = (lane & 15) * 8;
    const bf16x8 ov = ovr[it]; const bf16x8 gv = gvr[it];
    float f[8];
#pragma unroll
    for (int j = 0; j < 8; ++j) f[j] = bf2f((bf16_t)ov[j]) * siluf(bf2f((bf16_t)gv[j]));
    const u32x4 w = {cvt_pk_bf16(f[0], f[1]), cvt_pk_bf16(f[2], f[3]), cvt_pk_bf16(f[4], f[5]), cvt_pk_bf16(f[6], f[7])};
    *(u32x4*)(Ow + (long)row * 2048 + c8) = w; }
#undef SLOAD
#undef SWRITE
#undef SWAIT
#undef RESC
#undef KOFF
#undef DOMASK
}

#define MFMA16(a, b, c) __builtin_amdgcn_mfma_f32_16x16x32_bf16((a), (b), (c), 0, 0, 0)
__device__ __forceinline__ bf16x8 as_bf8(u32x4 w) { return *reinterpret_cast<bf16x8*>(&w); }
__device__ __forceinline__ void hgrn_chain(const Params& p, char* lds, int item) {
    int tid_ = threadIdx.x; asm volatile("" : "+v"(tid_));
    const int tid = tid_, wid = __builtin_amdgcn_readfirstlane(tid >> 6), lane = tid & 63, l16 = lane & 15, g = lane >> 4;
    const bool samp = item < 128; const int it = samp ? item : item - 128;
    const int b = it >> 4, h = (it >> 1) & 7, dir = it & 1;
    const int L = samp ? 2048 : 256; const long tok0 = samp ? NPTOK + (long)b * 2048 : (long)b * 256;
    const int nchunk = L >> 5;
    char* ws = p.ws; asm volatile("" : "+s"(ws));
    bf16_t* U = (bf16_t*)(ws + WS_U);
    const int d = l16 + 16 * wid, part = g;
    const int lt = tid >> 4, ld8 = (tid & 15) * 8;
    const float lbv = ((const float*)(ws + WS_LB))[dir * 1024 + h * 128 + d];
    constexpr int TILE_B = 38400;
    bf16_t* otile0 = (bf16_t*)(lds + 2 * TILE_B);
    bf16_t* raw = otile0 + 2 * 32 * 136;
    f32x4 S[8];
    if (samp) { const float* st = p.in[2] + (size_t)((b * 2 + dir) * 8 + h) * 16384;
#pragma unroll
        for (int m = 0; m < 8; ++m)
#pragma unroll
            for (int i = 0; i < 4; ++i) S[m][i] = st[(16 * m + 4 * g + i) * 128 + 16 * wid + l16];
    } else {
#pragma unroll
        for (int m = 0; m < 8; ++m) S[m] = (f32x4){0.f, 0.f, 0.f, 0.f};
    }
    const int gcol = 1024 * (1 + dir);
    bf16_t* ubase = U + h * 128 + ld8;
    bf16x8 rq, rf, ri;
#define HTOK(c) ((size_t)(tok0 + (dir ? (L - 1 - ((c) * 32 + lt)) : ((c) * 32 + lt))) * LDU0)
#define HLD(c) do { const bf16_t* u_ = ubase + HTOK(c); rq = *(const bf16x8*)(u_); rf = *(const bf16x8*)(u_ + gcol); ri = *(const bf16x8*)(u_ + 3072); } while (0)
#define HWR(c) do { bf16_t* r_ = raw + ((c) & 1) * (3 * 32 * 136) + lt * 136 + ld8; *(bf16x8*)(r_) = rq; *(bf16x8*)(r_ + 32 * 136) = rf; *(bf16x8*)(r_ + 2 * 32 * 136) = ri; } while (0)
#define HOST(c) do { *(bf16x8*)(U + HTOK(c) + gcol + h * 128 + ld8) = *(const bf16x8*)(otile0 + ((c) & 1) * (32 * 136) + lt * 136 + ld8); } while (0)
    HLD(0); HWR(0);
    if (nchunk > 1) HLD(1);
    __syncthreads();
    for (int c = 0; c < nchunk; ++c) {
        char* tb = lds + (c & 1) * TILE_B;
        bf16_t* qd = (bf16_t*)tb; bf16_t* ki = qd + 32 * 136; bf16_t* keT = ki + 32 * 136; bf16_t* vT = keT + 128 * 40; float* dec = (float*)(vT + 128 * 40);
        const bf16_t* rw = raw + (c & 1) * (3 * 32 * 136) + (part * 8) * 136 + d;
        float q[8], k[8], bl[8]; unsigned vv[4]; bf16_t rq_[8], rf_[8], ri_[8];
        float cum = 0.f;
#pragma unroll
        for (int tt = 0; tt < 8; ++tt) { rq_[tt] = rw[tt * 136]; rf_[tt] = rw[32 * 136 + tt * 136]; ri_[tt] = rw[2 * 32 * 136 + tt * 136]; }
        asm volatile("s_waitcnt lgkmcnt(0)" ::: "memory"); __builtin_amdgcn_sched_barrier(0);
#pragma unroll
        for (int tt = 0; tt < 8; ++tt) { q[tt] = siluf(bf2f(rq_[tt])); const float sg = __builtin_amdgcn_rcpf(1.f + fexp(-bf2f(rf_[tt])));
            const float f = lbv + (1.f - lbv) * sg; k[tt] = 1.f - f; cum += flog(f); bl[tt] = cum; }
#pragma unroll
        for (int tt = 0; tt < 4; ++tt) vv[tt] = (unsigned)ri_[2 * tt] | ((unsigned)ri_[2 * tt + 1] << 16);
        const float c1 = __shfl_xor(cum, 16), c2 = __shfl_xor(cum, 32), c3 = __shfl_xor(cum, 48);
        const float blast = cum + c1 + c2 + c3;
        const float off = ((part & 1) ? c1 : 0.f) + ((part & 2) ? c2 + c3 : 0.f);
        float ke[8]; const float eblast = fexp(blast);
#pragma unroll
        for (int tt = 0; tt < 8; ++tt) { const float bb = off + bl[tt]; const int t = part * 8 + tt;
            const float kiv = k[tt] * fexp(-bb); qd[t * 136 + d] = f2bf(q[tt] * fexp(bb)); ki[t * 136 + d] = f2bf(kiv); ke[tt] = kiv * eblast; }
        { u32x4 w = {cvt_pk_bf16(ke[0], ke[1]), cvt_pk_bf16(ke[2], ke[3]), cvt_pk_bf16(ke[4], ke[5]), cvt_pk_bf16(ke[6], ke[7])};
          *(u32x4*)(keT + d * 40 + part * 8) = w; u32x4 w2 = {vv[0], vv[1], vv[2], vv[3]}; *(u32x4*)(vT + d * 40 + part * 8) = w2; }
        if (part == 0) dec[d] = eblast;
        if (c >= 2) HOST(c - 2);
        if (c + 1 < nchunk) { HWR(c + 1); if (c + 2 < nchunk) HLD(c + 2); }
        __syncthreads();
        f32x4 T00 = {0.f, 0.f, 0.f, 0.f}, T01 = T00, T11 = T00;
#pragma unroll
        for (int ks = 0; ks < 4; ++ks) {
            const bf16x8 a0 = *(const bf16x8*)(ki + l16 * 136 + 32 * ks + 8 * g), a1 = *(const bf16x8*)(ki + (16 + l16) * 136 + 32 * ks + 8 * g);
            const bf16x8 b0 = *(const bf16x8*)(qd + l16 * 136 + 32 * ks + 8 * g), b1 = *(const bf16x8*)(qd + (16 + l16) * 136 + 32 * ks + 8 * g);
            T00 = MFMA16(a0, b0, T00); T01 = MFMA16(a0, b1, T01); T11 = MFMA16(a1, b1, T11);
        }
#pragma unroll
        for (int i = 0; i < 4; ++i) if (4 * g + i > l16) { T00[i] = 0.f; T11[i] = 0.f; }
        const u32x4 P0w = {cvt_pk_bf16(T00[0], T00[1]), cvt_pk_bf16(T00[2], T00[3]), 0u, 0u};
        const u32x4 P1w = {cvt_pk_bf16(T01[0], T01[1]), cvt_pk_bf16(T01[2], T01[3]), cvt_pk_bf16(T11[0], T11[1]), cvt_pk_bf16(T11[2], T11[3])};
        const bf16_t* vrow = vT + (16 * wid + l16) * 40;
        const u32x2 vlo = *(const u32x2*)(vrow + 4 * g), vhi = *(const u32x2*)(vrow + 16 + 4 * g);
        const u32x4 Bvw = {vlo[0], vlo[1], vhi[0], vhi[1]};
        f32x4 o0 = {0.f, 0.f, 0.f, 0.f}, o1 = o0;
        o0 = MFMA16(as_bf8(P0w), as_bf8(Bvw), o0); o1 = MFMA16(as_bf8(P1w), as_bf8(Bvw), o1);
#pragma unroll
        for (int ks = 0; ks < 4; ++ks) {
            const u32x2 x0 = *(const u32x2*)(qd + l16 * 136 + 32 * ks + 4 * g), x1 = *(const u32x2*)(qd + l16 * 136 + 32 * ks + 16 + 4 * g);
            const u32x2 y0 = *(const u32x2*)(qd + (16 + l16) * 136 + 32 * ks + 4 * g), y1 = *(const u32x2*)(qd + (16 + l16) * 136 + 32 * ks + 16 + 4 * g);
            const u32x4 A0w = {x0[0], x0[1], x1[0], x1[1]}, A1w = {y0[0], y0[1], y1[0], y1[1]};
            const u32x4 Bsw = {cvt_pk_bf16(S[2 * ks][0], S[2 * ks][1]), cvt_pk_bf16(S[2 * ks][2], S[2 * ks][3]),
                               cvt_pk_bf16(S[2 * ks + 1][0], S[2 * ks + 1][1]), cvt_pk_bf16(S[2 * ks + 1][2], S[2 * ks + 1][3])};
            o0 = MFMA16(as_bf8(A0w), as_bf8(Bsw), o0); o1 = MFMA16(as_bf8(A1w), as_bf8(Bsw), o1);
        }
        const bf16x8 bvv = *(const bf16x8*)(vrow + 8 * g);
#pragma unroll
        for (int m = 0; m < 8; ++m) { const f32x4 dc = *(const f32x4*)(dec + 16 * m + 4 * g); S[m] = S[m] * dc;
            const bf16x8 a = *(const bf16x8*)(keT + (16 * m + l16) * 40 + 8 * g); S[m] = MFMA16(a, bvv, S[m]); }
        bf16_t* otile = otile0 + (c & 1) * (32 * 136);
#pragma unroll
        for (int i = 0; i < 4; ++i) { otile[(4 * g + i) * 136 + 16 * wid + l16] = f2bf(o0[i]); otile[(16 + 4 * g + i) * 136 + 16 * wid + l16] = f2bf(o1[i]); }
    }
    __syncthreads();
    if (nchunk >= 2) HOST(nchunk - 2);
    HOST(nchunk - 1);
    if (!samp) { float* st = p.out + OUT_STATE + (size_t)((b * 2 + dir) * 8 + h) * 16384;
#pragma unroll
        for (int m = 0; m < 8; ++m)
#pragma unroll
            for (int i = 0; i < 4; ++i) st[(16 * m + 4 * g + i) * 128 + 16 * wid + l16] = S[m][i];
    }
#undef HLD
#undef HWR
#undef HTOK
#undef HOST
}

__device__ __forceinline__ void mod_gemv(const Params& p, char* lds, const int layer, const int first, const int stride) {
    const int tid = threadIdx.x;
    float* sl = (float*)lds;
    float* red = (float*)(lds + 73728);
    __syncthreads();
    for (int idx = tid; idx < 9 * 2048; idx += 512) { const int j = idx >> 11, k = idx & 2047; const float c = j ? p.in[7][(j - 1) * 2048 + k] : p.in[8][k]; sl[idx] = siluf(c); }
    __syncthreads();
    for (int colg = first; colg < 96; colg += stride) {
        const int lane = tid & 63, cq = lane & 15, kp = (tid >> 6) * 4 + (lane >> 4);
        const float* W = p.in[layer ? 19 : 11] + (size_t)(kp * 64) * 6144 + colg * 64 + cq * 4; const float* bm = p.in[layer ? 20 : 12];
        f32x4 acc[9];
#pragma unroll
        for (int j = 0; j < 9; ++j) acc[j] = (f32x4){0.f, 0.f, 0.f, 0.f};
        for (int k0 = 0; k0 < 64; k0 += 8) {
            f32x4 w[8];
#pragma unroll
            for (int u = 0; u < 8; ++u) w[u] = *(const f32x4*)(W + (size_t)(k0 + u) * 6144);
#pragma unroll
            for (int j = 0; j < 9; ++j) { const f32x4 s0 = *(const f32x4*)(sl + j * 2048 + kp * 64 + k0), s1 = *(const f32x4*)(sl + j * 2048 + kp * 64 + k0 + 4);
                acc[j] += w[0] * s0[0] + w[1] * s0[1] + w[2] * s0[2] + w[3] * s0[3] + w[4] * s1[0] + w[5] * s1[1] + w[6] * s1[2] + w[7] * s1[3]; }
        }
#pragma unroll
        for (int j = 0; j < 9; ++j)
#pragma unroll
            for (int e = 0; e < 4; ++e) { float v = acc[j][e]; v += __shfl_xor(v, 16); v += __shfl_xor(v, 32); acc[j][e] = v; }
        if (lane < 16) {
#pragma unroll
            for (int j = 0; j < 9; ++j) *(f32x4*)(red + ((tid >> 6) * 9 + j) * 64 + cq * 4) = acc[j]; }
        __syncthreads();
        for (int idx = tid; idx < 576; idx += 512) { const int j = idx >> 6, c2 = idx & 63; float s_ = 0.f;
#pragma unroll
            for (int q = 0; q < 8; ++q) s_ += red[(q * 9 + j) * 64 + c2];
            ((float*)(p.ws + WS_MOD))[(layer * 9 + j) * 6144 + colg * 64 + c2] = s_ + bm[colg * 64 + c2]; }
        __syncthreads();
    }
}
__device__ __forceinline__ void wt_tasks(const Params& p, char* lds, const int t0, const int cnt) {
    const int tid = threadIdx.x;
    bf16_t* T = (bf16_t*)lds;
    __syncthreads();
    for (int t = t0; t < t0 + cnt; ++t) {
        const int ct = t >> 4, kt = t & 15; const float* W; bf16_t* WT; int N, nt;
        if (ct < 120) { W = p.in[13]; WT = (bf16_t*)(p.ws + WS_WT_IN0); N = 7680; nt = ct; }
        else if (ct < 152) { W = p.in[14]; WT = (bf16_t*)(p.ws + WS_WT_OUT0); N = 2048; nt = ct - 120; }
        else if (ct < 232) { W = p.in[21]; WT = (bf16_t*)(p.ws + WS_WT_IN1); N = 5120; nt = ct - 152; }
        else { W = p.in[22]; WT = (bf16_t*)(p.ws + WS_WT_OUT1); N = 2048; nt = ct - 232; }
        const int r = tid >> 4, c4 = (tid & 15) * 4;
#pragma unroll
        for (int itr = 0; itr < 4; ++itr) { const int kk = itr * 32 + r; const f32x4 v = *(const f32x4*)(W + (size_t)(kt * 128 + kk) * N + nt * 64 + c4);
#pragma unroll
            for (int e = 0; e < 4; ++e) T[(c4 + e) * 136 + kk] = f2bf(v[e]); }
        __syncthreads();
        { const int n = tid >> 3, k16 = (tid & 7) * 16; bf16_t* dst = WT + (size_t)(nt * 64 + n) * 2048 + kt * 128 + k16;
          *(u32x4*)dst = *(const u32x4*)(T + n * 136 + k16); *(u32x4*)(dst + 8) = *(const u32x4*)(T + n * 136 + k16 + 8); }
        __syncthreads();
    }
}
__device__ __forceinline__ void phase_prologue(const Params& p, char* lds) {
    const int tid = threadIdx.x, c = (int)blockIdx.x;
    if (c < 96) mod_gemv(p, lds, 0, c, 96);
    if (c == (int)gridDim.x - 1) {
        for (int idx = tid; idx < 2048; idx += 512) { const float g0 = p.in[9][idx], g1 = p.in[9][2048 + idx], g2 = p.in[9][4096 + idx];
            const float m = fmaxf(g0, fmaxf(g1, g2)); const float e0 = __expf(g0 - m), e1 = __expf(g1 - m), e2 = __expf(g2 - m);
            ((float*)(p.ws + WS_LB))[idx] = e0 / (e0 + e1 + e2); }
    }
    if (c < 96) wt_tasks(p, lds, c * 5, 5); else wt_tasks(p, lds, 480 + (c - 96) * 9, 9);
}
__device__ __forceinline__ void tail_fill_p2(const Params& p, char* lds) {
    const int idx = (int)blockIdx.x - 96; if (idx < 0) return;
    if (idx < 96) { mod_gemv(p, lds, 1, idx, 96); wt_tasks(p, lds, 1920 + idx * 10, 10); }
    else wt_tasks(p, lds, 1920 + 960 + (idx - 96) * 13, 13);
}
__device__ __forceinline__ void tail_fill_p6(const Params& p, char* lds) {
    const int idx = (int)blockIdx.x - 128; if (idx < 0) return;
    wt_tasks(p, lds, 3712 + idx * 4, 4);
}

__device__ __forceinline__ void phase_norm(const float* xa, const float* xb, const float* g, const float* mod, bf16_t* H) {
    const int lane = threadIdx.x & 63, gw = blockIdx.x * 8 + (threadIdx.x >> 6), nw = gridDim.x * 8;
#define NCOL(i) ((((i) >> 1) * 64 + lane) * 8 + ((i) & 1) * 4)
    for (int row = gw; row < NTOK; row += 2 * nw) {
        const int row2 = row + nw; const bool has2 = row2 < NTOK; const int r2 = has2 ? row2 : row;
        const float* src = row < NPTOK ? xa + (size_t)row * 2048 : xb + (size_t)(row - NPTOK) * 2048;
        const float* src2 = r2 < NPTOK ? xa + (size_t)r2 * 2048 : xb + (size_t)(r2 - NPTOK) * 2048;
        f32x4 v[8], v2[8]; float ss = 0.f, ss2 = 0.f;
#pragma unroll
        for (int i = 0; i < 8; ++i) v[i] = *(const f32x4*)(src + NCOL(i));
#pragma unroll
        for (int i = 0; i < 8; ++i) v2[i] = *(const f32x4*)(src2 + NCOL(i));
#pragma unroll
        for (int i = 0; i < 8; ++i) ss += v[i][0] * v[i][0] + v[i][1] * v[i][1] + v[i][2] * v[i][2] + v[i][3] * v[i][3];
#pragma unroll
        for (int i = 0; i < 8; ++i) ss2 += v2[i][0] * v2[i][0] + v2[i][1] * v2[i][1] + v2[i][2] * v2[i][2] + v2[i][3] * v2[i][3];
        ss = wave_sum(ss); ss2 = wave_sum(ss2);
        const float rstd = rsqrtf(ss * (1.f / 2048.f) + 1e-6f), rstd2 = rsqrtf(ss2 * (1.f / 2048.f) + 1e-6f);
        const int j = row < NPTOK ? 0 : 1 + ((row - NPTOK) >> 11), j2 = r2 < NPTOK ? 0 : 1 + ((r2 - NPTOK) >> 11);
        const float* sh = mod + j * 6144; const float* sc = sh + 2048; const float* sh2 = mod + j2 * 6144; const float* sc2 = sh2 + 2048;
#pragma unroll
        for (int ip = 0; ip < 4; ++ip) { const int col = (ip * 64 + lane) * 8;
            const f32x4 ga = *(const f32x4*)(g + col), gb = *(const f32x4*)(g + col + 4);
            { const f32x4 ya = v[2 * ip] * rstd * ga * (*(const f32x4*)(sc + col) + 1.f) + *(const f32x4*)(sh + col), yb = v[2 * ip + 1] * rstd * gb * (*(const f32x4*)(sc + col + 4) + 1.f) + *(const f32x4*)(sh + col + 4);
              const u32x4 w = {cvt_pk_bf16(ya[0], ya[1]), cvt_pk_bf16(ya[2], ya[3]), cvt_pk_bf16(yb[0], yb[1]), cvt_pk_bf16(yb[2], yb[3])}; *(u32x4*)(H + (size_t)row * 2048 + col) = w; }
            if (has2) { const f32x4 ya = v2[2 * ip] * rstd2 * ga * (*(const f32x4*)(sc2 + col) + 1.f) + *(const f32x4*)(sh2 + col), yb = v2[2 * ip + 1] * rstd2 * gb * (*(const f32x4*)(sc2 + col + 4) + 1.f) + *(const f32x4*)(sh2 + col + 4);
              const u32x4 w = {cvt_pk_bf16(ya[0], ya[1]), cvt_pk_bf16(ya[2], ya[3]), cvt_pk_bf16(yb[0], yb[1]), cvt_pk_bf16(yb[2], yb[3])}; *(u32x4*)(H + (size_t)row2 * 2048 + col) = w; } }
    }
#undef NCOL
}

template <int LAYER>
__device__ __forceinline__ void phase_prep(const Params& p) {
    constexpr int LDU = LAYER ? LDU1 : LDU0, QOFF = LAYER ? 0 : 5120, NQH = LAYER ? 16 : 8, KOFF_ = LAYER ? 2048 : 6144, NKH = LAYER ? 4 : 2;
    constexpr int NQS = NQH / 4, NKS = (2 * NKH) / 4;
    const float* qn = p.in[LAYER ? 23 : 16]; const float* kn = p.in[LAYER ? 24 : 17];
    float* outk = p.out + (LAYER ? OUT_L1K : OUT_L0K); float* outv = p.out + (LAYER ? OUT_L1V : OUT_L0V);
    const float* ck = p.in[LAYER ? 5 : 3]; const float* cv = p.in[LAYER ? 6 : 4];
    bf16_t* U = (bf16_t*)(p.ws + WS_U); bf16_t* KS = (bf16_t*)(p.ws + WS_KS); bf16_t* VS = (bf16_t*)(p.ws + WS_VS); bf16_t* KP = (bf16_t*)(p.ws + WS_KP); bf16_t* VP = (bf16_t*)(p.ws + WS_VP);
    const int lane = threadIdx.x & 63, gw = blockIdx.x * 8 + (threadIdx.x >> 6), nw = gridDim.x * 8;
    const int sub = lane >> 4, l16 = lane & 15, c8 = l16 * 8, a = (l16 >> 3) & 1, i0 = (l16 & 3) * 8;
    const float sgn = ((l16 >> 2) & 1) ? 1.f : -1.f;
    float qw[8], kw[8], inv[8];
#pragma unroll
    for (int j = 0; j < 8; ++j) { qw[j] = qn[c8 + j]; kw[j] = kn[c8 + j]; inv[j] = exp2f(-(float)(i0 + j) * (13.287712379549449f / 32.f)) * 0.15915494309189535f; }
    for (int tok = gw; tok < NTOK; tok += nw) {
        const bool samp = tok >= NPTOK; int b, t; if (samp) { b = (tok - NPTOK) >> 11; t = (tok - NPTOK) & 2047; } else { b = tok >> 8; t = tok & 255; }
        bf16_t* u = U + (size_t)tok * LDU + c8;
        bf16x8 xq[NQS], xkv[NKS];
#pragma unroll
        for (int s_ = 0; s_ < NQS; ++s_) xq[s_] = *(const bf16x8*)(u + QOFF + (s_ * 4 + sub) * 128);
#pragma unroll
        for (int s_ = 0; s_ < NKS; ++s_) xkv[s_] = *(const bf16x8*)(u + KOFF_ + (s_ * 4 + sub) * 128);
        float cs[8], sn[8];
#pragma unroll
        for (int j = 0; j < 8; ++j) { cs[j] = 1.f; sn[j] = 0.f; }
        if (samp) { const float pos = (float)(a ? (t & 63) : (t >> 6));
#pragma unroll
            for (int j = 0; j < 8; ++j) { float r = pos * inv[j]; r -= floorf(r); sn[j] = __builtin_amdgcn_sinf(r) * sgn; cs[j] = __builtin_amdgcn_cosf(r); } }
#pragma unroll
        for (int s_ = 0; s_ < NQS; ++s_) { float y[8], ss = 0.f;
#pragma unroll
            for (int j = 0; j < 8; ++j) { y[j] = bf2f((bf16_t)xq[s_][j]); ss += y[j] * y[j]; }
            ss = row16_sum(ss);
            const float rstd = rsqrtf(ss * (1.f / 128.f) + 1e-6f);
#pragma unroll
            for (int j = 0; j < 8; ++j) y[j] *= rstd * qw[j];
            float o[8];
#pragma unroll
            for (int j = 0; j < 8; ++j) o[j] = y[j] * cs[j] + __shfl_xor(y[j], 4) * sn[j];
            const u32x4 w = {cvt_pk_bf16(o[0], o[1]), cvt_pk_bf16(o[2], o[3]), cvt_pk_bf16(o[4], o[5]), cvt_pk_bf16(o[6], o[7])};
            *(u32x4*)(u + QOFF + (s_ * 4 + sub) * 128) = w; }
#pragma unroll
        for (int s_ = 0; s_ < NKS; ++s_) { const int slot = s_ * 4 + sub; const bool isk = slot < NKH; const int h = isk ? slot : slot - NKH;
            float x[8], y[8], ss = 0.f;
#pragma unroll
            for (int j = 0; j < 8; ++j) { x[j] = bf2f((bf16_t)xkv[s_][j]); ss += x[j] * x[j]; }
            ss = row16_sum(ss);
            const float rstd = rsqrtf(ss * (1.f / 128.f) + 1e-6f);
#pragma unroll
            for (int j = 0; j < 8; ++j) y[j] = x[j] * rstd * kw[j];
            float o[8];
#pragma unroll
            for (int j = 0; j < 8; ++j) { const float z = __shfl_xor(y[j], 4); o[j] = isk ? (y[j] * cs[j] + z * sn[j]) : x[j]; }
            const u32x4 w = {cvt_pk_bf16(o[0], o[1]), cvt_pk_bf16(o[2], o[3]), cvt_pk_bf16(o[4], o[5]), cvt_pk_bf16(o[6], o[7])};
            if (!samp) { float* of = (isk ? outk : outv) + ((size_t)tok * NKH + h) * 128 + c8;
                *(f32x4*)of = (f32x4){o[0], o[1], o[2], o[3]}; *(f32x4*)(of + 4) = (f32x4){o[4], o[5], o[6], o[7]};
                *(u32x4*)((isk ? KP : VP) + ((size_t)(b * NKH + h) * 256 + t) * 128 + c8) = w; }
            else *(u32x4*)((isk ? KS : VS) + ((size_t)(b * NKH + h) * 2304 + t) * 128 + c8) = w; }
    }
    for (int r4 = gw * 4; r4 < 8 * 256 * NKH; r4 += nw * 4) { const int r = r4 + sub; const int b = r / (256 * NKH), j = (r / NKH) & 255, h = r % NKH;
        const size_t o = ((size_t)(b * NKH + h) * 2304 + 2048 + j) * 128 + c8;
        const f32x4 k0 = *(const f32x4*)(ck + (size_t)r * 128 + c8), k1 = *(const f32x4*)(ck + (size_t)r * 128 + c8 + 4), v0 = *(const f32x4*)(cv + (size_t)r * 128 + c8), v1 = *(const f32x4*)(cv + (size_t)r * 128 + c8 + 4);
        const u32x4 wk = {cvt_pk_bf16(k0[0], k0[1]), cvt_pk_bf16(k0[2], k0[3]), cvt_pk_bf16(k1[0], k1[1]), cvt_pk_bf16(k1[2], k1[3])};
        const u32x4 wv = {cvt_pk_bf16(v0[0], v0[1]), cvt_pk_bf16(v0[2], v0[3]), cvt_pk_bf16(v1[0], v1[1]), cvt_pk_bf16(v1[2], v1[3])};
        *(u32x4*)(KS + o) = wk; *(u32x4*)(VS + o) = wv; }
}

__device__ __forceinline__ void phase_comb0(const Params& p) {
    const bf16_t* U = (const bf16_t*)(p.ws + WS_U); bf16_t* MIX = (bf16_t*)(p.ws + WS_H);
    const int lane = threadIdx.x & 63, gw = blockIdx.x * 8 + (threadIdx.x >> 6), nw = gridDim.x * 8;
    const int sub = lane >> 4, c8 = (lane & 15) * 8;
    const f32x4 onA = *(const f32x4*)(p.in[15] + c8), onB = *(const f32x4*)(p.in[15] + c8 + 4);
    for (int tok = gw; tok < NTOK; tok += 2 * nw) {
        const int tok2 = tok + nw; const bool has2 = tok2 < NTOK;
        bf16x8 vf[4], vb[4], vg[4];
#pragma unroll
        for (int q = 0; q < 4; ++q) { const int tk = (q < 2 || has2) ? ((q < 2) ? tok : tok2) : tok; const bf16_t* u = U + (size_t)tk * LDU0 + ((q & 1) * 4 + sub) * 128 + c8;
            vf[q] = *(const bf16x8*)(u + 1024); vb[q] = *(const bf16x8*)(u + 2048); vg[q] = *(const bf16x8*)(u + 4096); }
#pragma unroll
        for (int q = 0; q < 4; ++q) { if (q >= 2 && !has2) break;
            float sv[8], ss = 0.f;
#pragma unroll
            for (int j = 0; j < 8; ++j) { sv[j] = bf2f((bf16_t)vf[q][j]) + bf2f((bf16_t)vb[q][j]); ss += sv[j] * sv[j]; }
            ss = row16_sum(ss);
            const float rstd = rsqrtf(ss * (1.f / 128.f) + 1e-6f);
            float f[8];
#pragma unroll
            for (int j = 0; j < 8; ++j) f[j] = sv[j] * rstd * (j < 4 ? onA[j] : onB[j - 4]) * siluf(bf2f((bf16_t)vg[q][j]));
            const u32x4 w = {cvt_pk_bf16(f[0], f[1]), cvt_pk_bf16(f[2], f[3]), cvt_pk_bf16(f[4], f[5]), cvt_pk_bf16(f[6], f[7])};
            const int tk = q < 2 ? tok : tok2;
            *(u32x4*)(MIX + (size_t)tk * 2048 + ((q & 1) * 4 + sub) * 128 + c8) = w; }
    }
}

__device__ __forceinline__ void attn0_run(const Params& p, char* lds, bool samp, int b, int h, int qb) {
    char* ws = p.ws; asm volatile("" : "+s"(ws));
    const bf16_t* U = (const bf16_t*)(ws + WS_U); bf16_t* MIX = (bf16_t*)(ws + WS_H); const int kvh = h >> 2;
    const size_t row = samp ? NPTOK + (size_t)b * 2048 + qb * 256 : (size_t)b * 256;
    const size_t kvo = samp ? (size_t)(b * 2 + kvh) * 2304 * 128 : (size_t)(b * 2 + kvh) * 256 * 128;
    const bf16_t* Kp = (const bf16_t*)(ws + (samp ? WS_KS : WS_KP)) + kvo; const bf16_t* Vp = (const bf16_t*)(ws + (samp ? WS_VS : WS_VP)) + kvo;
    attn_body<LDU0>(U + row * LDU0 + 5120 + h * 128, Kp, Vp, U + row * LDU0 + 6656 + h * 128, MIX + row * 2048 + 1024 + h * 128,
                    samp ? 36 : 4, samp ? 4 : 0, samp ? 2048 : 0, 0, false, qb * 256, nullptr, lds);
}
__device__ __forceinline__ void attn_item1(const Params& p, char* lds, int a) {
    char* ws = p.ws; asm volatile("" : "+s"(ws));
    const bf16_t* U = (const bf16_t*)(ws + WS_U); bf16_t* MIX = (bf16_t*)(ws + WS_H);
    const bool samp = a < 1024;
    int b, kvh, h0, i0, ls, le; size_t row, kvo;
    if (samp) { const int x_ = a & 7, tb = (a >> 3) & 31, set_ = x_ + 8 * (a >> 8);
        b = set_ >> 2; kvh = set_ & 3; h0 = kvh * 4; i0 = tb * 64; row = NPTOK + (size_t)b * 2048 + i0; kvo = (size_t)(b * 4 + kvh) * 2304 * 128;
        ls = tb - 2 < 0 ? 0 : tb - 2; le = tb + 3 > 32 ? 32 : tb + 3;
    } else { const int a2 = a - 1024; b = a2 >> 4; h0 = a2 & 15; kvh = h0 >> 2; i0 = 0; row = (size_t)b * 256; kvo = (size_t)(b * 4 + kvh) * 256 * 128; ls = 0; le = 4; }
    const bf16_t* Kp = (const bf16_t*)(ws + (samp ? WS_KS : WS_KP)) + kvo; const bf16_t* Vp = (const bf16_t*)(ws + (samp ? WS_VS : WS_VP)) + kvo;
    attn_body<LDU1>(U + row * LDU1 + h0 * 128, Kp, Vp, U + row * LDU1 + 3072 + h0 * 128, MIX + row * 2048 + h0 * 128,
                    samp ? 4 + le - ls : 4, samp ? 4 : 0, samp ? 2048 : 0, ls, samp, i0, p.in[25] + h0, lds, samp);
}

template <class Epi>
__device__ __forceinline__ void phase_gemm(unsigned char* shm, const bf16_t* A, const bf16_t* Bt, int N, const Epi& E) {
    Gemm g; g.A = A; g.Bt = Bt; g.M = NTOK; g.N = N; g.K = 2048;
    StaticOrder S; S.init(NTOK, N, (int)gridDim.x, (int)blockIdx.x);
    gemm_phase<Epi, StaticOrder, false>((PG8_LAS unsigned char*)shm, g, S, E, nullptr);
}

#define XB_TMO      128
#define XB_XCNT(j)  (256  + 64 * (j))
#define XB_XSUB(j)  (1280 + 64 * (j))
#define XB_XGEN(j)  (2304 + 64 * (j))
#define XB_TOP      3328
#define XB_TOPGEN   3392
#define XCD_BAR_WORDS 3456
#define XB_SPIN_CAP (1u << 18)
#define LAS __attribute__((address_space(3)))

__device__ __forceinline__ unsigned xb_ld(unsigned* p)              { return __hip_atomic_load(p, __ATOMIC_RELAXED, __HIP_MEMORY_SCOPE_AGENT); }
__device__ __forceinline__ unsigned xb_add(unsigned* p, unsigned v) { return __hip_atomic_fetch_add(p, v, __ATOMIC_RELAXED, __HIP_MEMORY_SCOPE_AGENT); }
__device__ __forceinline__ unsigned xb_xcc_id() { return (unsigned)__builtin_amdgcn_s_getreg((3 << 11) | 20) & 0xFu; }
#define XB_SPIN(cond, bar) do { unsigned _sp = 0; while (cond) { __builtin_amdgcn_s_sleep(1); \
    if ((++_sp & 255u) == 0u) { if (xb_ld(&(bar)[XB_TMO])) break; if (_sp > XB_SPIN_CAP) { atomicAdd(&(bar)[XB_TMO], 1u); break; } } } } while (0)

struct XcdBarrier {
    unsigned* bar; unsigned x;
    volatile LAS unsigned* st;
};

__device__ __forceinline__ XcdBarrier xcd_barrier_post(unsigned* bar, volatile LAS unsigned* st) {
    XcdBarrier b; b.bar = bar; b.x = xb_xcc_id(); b.st = st;
    if (threadIdx.x == 0) (void)xb_add(&bar[XB_XCNT(b.x)], 1u);
    return b;
}
__device__ __forceinline__ void xcd_barrier_complete(unsigned* bar, unsigned x, unsigned& nloc, unsigned& nx) {
    const unsigned G = gridDim.x * gridDim.y * gridDim.z;
    unsigned sum, cnt, mine, sp = 0u;
    for (;;) {
        sum = 0u; cnt = 0u; mine = 0u;
#pragma unroll
        for (unsigned j = 0; j < 16; ++j) { const unsigned c = xb_ld(&bar[XB_XCNT(j)]); sum += c; cnt += (c > 0u) ? 1u : 0u; mine = (j == x) ? c : mine; }
        if (sum == G) break;
        __builtin_amdgcn_s_sleep(1);
        if ((++sp & 255u) == 0u) { if (xb_ld(&bar[XB_TMO])) break; if (sp > XB_SPIN_CAP) { atomicAdd(&bar[XB_TMO], 1u); break; } }
    }
    nloc = mine > 0u ? mine : 1u; nx = cnt > 0u ? cnt : 1u;
}

__device__ __forceinline__ void xcd_barrier(const XcdBarrier& b) {
    asm volatile("s_waitcnt vmcnt(0)" ::: "memory");
    __syncthreads();
    if (threadIdx.x == 0) {
        unsigned* bar = b.bar;
        __builtin_amdgcn_s_waitcnt(0);
        unsigned nloc = b.st[0], nx = b.st[1];
        if (nloc == 0u) { xcd_barrier_complete(bar, b.x, nloc, nx); b.st[0] = nloc; b.st[1] = nx; }
        const unsigned old = xb_add(&bar[XB_XSUB(b.x)], 1u);
        const unsigned gen = old / nloc;
        if (old + 1u == (gen + 1u) * nloc) {
            __builtin_amdgcn_fence(__ATOMIC_RELEASE, "agent");
            asm volatile("s_waitcnt vmcnt(0)" ::: "memory");
            const unsigned og = xb_add(&bar[XB_TOP], 1u);
            const unsigned tg = og / nx;
            if (og + 1u == (tg + 1u) * nx) xb_add(&bar[XB_TOPGEN], 1u);
            else XB_SPIN(xb_ld(&bar[XB_TOPGEN]) == tg, bar);
            __builtin_amdgcn_fence(__ATOMIC_ACQUIRE, "agent");
            xb_add(&bar[XB_XGEN(b.x)], 1u);
            asm volatile("s_waitcnt vmcnt(0)" ::: "memory");
        } else {
            XB_SPIN(xb_ld(&bar[XB_XGEN(b.x)]) == gen, bar);
            __builtin_amdgcn_fence(__ATOMIC_ACQUIRE, "agent");
            asm volatile("s_waitcnt vmcnt(0)" ::: "memory");
        }
    }
    __syncthreads();
}


constexpr int NPHASE = 12;
#define XB_NOW() do { XcdBarrier b_; b_.bar = (unsigned*)(p.ws + WS_BAR); b_.x = xb_xcc_id(); b_.st = (volatile LAS unsigned*)(shm + LDS_BYTES); xcd_barrier(b_); } while (0)
#if MK_MULTI
#define GSYNC(n) do { if (ph0 <= (n) && (n) + 1 < ph1) XB_NOW(); } while (0)
#define PH_ON(n) (ph0 <= (n) && (n) < ph1)
#else
#define GSYNC(n) do { if (ph0 <= (n) && (n) + 1 < ph1) XB_NOW(); } while (0)
#define PH_ON(n) (ph0 <= (n) && (n) < ph1)
#endif
__global__ void __launch_bounds__(512) mega(Params p, int ph0, int ph1) {
    extern __shared__ __attribute__((aligned(16))) unsigned char shm[];
    char* lds = (char*)shm;
    volatile LAS unsigned* xst = (volatile LAS unsigned*)(shm + LDS_BYTES);
    if (threadIdx.x == 0) { xst[0] = 0u; xst[1] = 0u; }
    __syncthreads();
    (void)xcd_barrier_post((unsigned*)(p.ws + WS_BAR), xst);
    if (p.ws == nullptr) cg::this_grid().sync();
#if (PHSEL >> 0) & 1
    if (PH_ON(0)) for (int rep = 0; rep <= ((REPMASK >> 0) & 1); ++rep) { if (rep) XB_NOW(); phase_prologue(p, lds);
        }
    GSYNC(0);
#endif
#if (PHSEL >> 1) & 1
    if (PH_ON(1)) for (int rep = 0; rep <= ((REPMASK >> 1) & 1); ++rep) { if (rep) XB_NOW(); phase_norm(p.in[0], p.in[1], p.in[10], (const float*)(p.ws + WS_MOD), (bf16_t*)(p.ws + WS_H));
        }
    GSYNC(1);
#endif
#if (PHSEL >> 2) & 1
    if (PH_ON(2)) for (int rep = 0; rep <= ((REPMASK >> 2) & 1); ++rep) { if (rep) XB_NOW(); { EpiU E; E.O = (bf16_t*)(p.ws + WS_U); E.ldc = LDU0; phase_gemm(shm, (const bf16_t*)(p.ws + WS_H), (const bf16_t*)(p.ws + WS_WT_IN0), 7680, E); }
        if (!rep) tail_fill_p2(p, lds);
        }
    GSYNC(2);
#endif
#if (PHSEL >> 3) & 1
    if (PH_ON(3)) for (int rep = 0; rep <= ((REPMASK >> 3) & 1); ++rep) { if (rep) XB_NOW(); phase_prep<0>(p);
        }
    GSYNC(3);
#endif
#if (PHSEL >> 4) & 1
    if (PH_ON(4)) for (int rep = 0; rep <= ((REPMASK >> 4) & 1); ++rep) { if (rep) XB_NOW();
            unsigned* qctr = (unsigned*)(p.ws + WS_BAR) + 3584;
            volatile LAS unsigned* slot = (volatile LAS unsigned*)(shm + LDS_BYTES + 8);
            const unsigned x0 = xb_xcc_id() & 7u;
            for (unsigned xo = 0; xo < 8u; ++xo) { const unsigned x = (x0 + xo) & 7u;
                for (;;) {
                    __syncthreads();
                    if (threadIdx.x == 0) *slot = __hip_atomic_fetch_add(qctr + 64 * x, 1u, __ATOMIC_RELAXED, __HIP_MEMORY_SCOPE_AGENT);
                    __syncthreads();
                    const int q = (int)*slot;
                    if (q >= 128 || rep) break;
                    if (q < 16 || (q >= 80 && q < 112)) hgrn_chain(p, lds, q < 16 ? (int)x * 16 + q : 128 + (int)x * 32 + (q - 80));
                    else if (q < 80) { const int j = q - 16, set_ = (int)x + 8 * (j >> 5), li = j & 31; attn0_run(p, lds, true, set_ >> 1, (set_ & 1) * 4 + (li >> 3), li & 7); }
                    else { const int a2 = (int)x * 16 + (q - 112); attn0_run(p, lds, false, a2 >> 3, a2 & 7, 0); }
                }
            }

        }
    GSYNC(4);
#endif
#if (PHSEL >> 5) & 1
    if (PH_ON(5)) for (int rep = 0; rep <= ((REPMASK >> 5) & 1); ++rep) { if (rep) XB_NOW(); phase_comb0(p);
        }
    GSYNC(5);
#endif
#if (PHSEL >> 6) & 1
    if (PH_ON(6)) for (int rep = 0; rep <= ((REPMASK >> 6) & 1); ++rep) { if (rep) XB_NOW(); { EpiRes E; E.Y = p.out; E.xp = p.in[0]; E.xs = p.in[1]; E.mod = (const float*)(p.ws + WS_MOD);
                  phase_gemm(shm, (const bf16_t*)(p.ws + WS_H), (const bf16_t*)(p.ws + WS_WT_OUT0), 2048, E); }
        if (!rep) tail_fill_p6(p, lds);
        }
    GSYNC(6);
#endif
#if (PHSEL >> 7) & 1
    if (PH_ON(7)) for (int rep = 0; rep <= ((REPMASK >> 7) & 1); ++rep) { if (rep) XB_NOW(); phase_norm(p.out, p.out + (size_t)NPTOK * 2048, p.in[18], (const float*)(p.ws + WS_MOD) + 9 * 6144, (bf16_t*)(p.ws + WS_H));
        }
    GSYNC(7);
#endif
#if (PHSEL >> 8) & 1
    if (PH_ON(8)) for (int rep = 0; rep <= ((REPMASK >> 8) & 1); ++rep) { if (rep) XB_NOW(); { EpiU E; E.O = (bf16_t*)(p.ws + WS_U); E.ldc = LDU1; phase_gemm(shm, (const bf16_t*)(p.ws + WS_H), (const bf16_t*)(p.ws + WS_WT_IN1), 5120, E); }
        }
    GSYNC(8);
#endif
#if (PHSEL >> 9) & 1
    if (PH_ON(9)) for (int rep = 0; rep <= ((REPMASK >> 9) & 1); ++rep) { if (rep) XB_NOW(); phase_prep<1>(p);
        }
    GSYNC(9);
#endif
#if (PHSEL >> 10) & 1
    if (PH_ON(10)) for (int rep = 0; rep <= ((REPMASK >> 10) & 1); ++rep) { if (rep) XB_NOW();
            for (int item = blockIdx.x; item < 1280; item += gridDim.x) { __syncthreads(); attn_item1(p, lds, item); }

        }
    GSYNC(10);
#endif
#if (PHSEL >> 11) & 1
    if (PH_ON(11)) for (int rep = 0; rep <= ((REPMASK >> 11) & 1); ++rep) { if (rep) XB_NOW(); { EpiRes E; E.Y = p.out; E.xp = p.out; E.xs = p.out + (size_t)NPTOK * 2048; E.mod = (const float*)(p.ws + WS_MOD) + 9 * 6144;
                   phase_gemm(shm, (const bf16_t*)(p.ws + WS_H), (const bf16_t*)(p.ws + WS_WT_OUT1), 2048, E); }
        }
    GSYNC(11);
#endif
}

extern "C" void kernel_launch(void* const* d_in, const int* in_sizes, int n_in, void* d_out, int out_size, void* d_ws, size_t ws_size, hipStream_t stream) {
    static int grid_blocks = 0;
    if (!grid_blocks) {
        if (ws_size < WS_END) { fprintf(stderr, "workspace too small: %zu < %zu\n", ws_size, WS_END); return; }
        if (hipFuncSetAttribute((const void*)mega, hipFuncAttributeMaxDynamicSharedMemorySize, LDS_BYTES + 16) != hipSuccess) { fprintf(stderr, "hipFuncSetAttribute failed\n"); return; }
        int dev = 0, cus = 0, per_cu = 0;
        hipGetDevice(&dev);
        hipDeviceGetAttribute(&cus, hipDeviceAttributeMultiprocessorCount, dev);
        hipOccupancyMaxActiveBlocksPerMultiprocessor(&per_cu, mega, 512, LDS_BYTES + 16);
        if (per_cu < 1) { fprintf(stderr, "occupancy query returned %d\n", per_cu); return; }
        if (cus != 256) { fprintf(stderr, "this kernel's static work split assumes 256 CUs (MI355X), found %d\n", cus); return; }
        grid_blocks = 256;
    }
    Params p{};
    for (int i = 0; i < 26; ++i) p.in[i] = (const float*)d_in[i];
    p.out = (float*)d_out; p.ws = (char*)d_ws;
    hipMemsetAsync((char*)d_ws + WS_BAR, 0, 16384, stream);
#if MK_MULTI
    for (int ph = 0; ph < NPHASE; ++ph) hipLaunchKernelGGL(mega, dim3(grid_blocks), dim3(512), LDS_BYTES + 16, stream, p, ph, ph + 1);
#else
    int ph0 = 0, ph1 = NPHASE;
    void* args[] = {&p, &ph0, &ph1};
    hipError_t e = hipLaunchCooperativeKernel((void*)mega, dim3(grid_blocks), dim3(512), args, LDS_BYTES + 16, stream);
    if (e != hipSuccess) fprintf(stderr, "cooperative launch failed: %s (grid %d)\n", hipGetErrorString(e), grid_blocks);
#endif
}
```
